# Optimizing an MI355X kernel written in HIP

```python
import jax, jax.numpy as jnp
from jax import lax
import numpy as np

D_MODEL = 2048
BATCH = 1
SEQ = 16384
DEPTH = 1

D_FF = 5632
RMS_EPS = 1e-6
ROPE_THETA = 500000.0
A_HEAD_DIM = 128
A_HEADS = D_MODEL // (2 * A_HEAD_DIM)
A_WIDTH = A_HEADS * A_HEAD_DIM
ROPE_DIM = A_HEAD_DIM // 4
DILATED_PATTERNS = ((128, 1), (512, 4), (2048, 16))
A_BLOCK = 128
MAX_DILATION = 16
B_HEADS = 4
B_VAL_DIM = D_MODEL // (2 * B_HEADS)
B_KEY_DIM = B_VAL_DIM // 2
B_KEY_WIDTH = B_HEADS * B_KEY_DIM
B_VAL_WIDTH = B_HEADS * B_VAL_DIM
GATE_RANK = 16
GATE_NORMALIZER = 16.0
GLA_CHUNK = 64
GLA_SUB = 16
IN_SPLITS = (A_WIDTH, A_WIDTH, A_WIDTH,
             B_KEY_WIDTH, B_KEY_WIDTH, B_VAL_WIDTH, B_VAL_WIDTH, GATE_RANK,
             D_MODEL, D_MODEL)
IN_WIDTH = sum(IN_SPLITS)

kernel_name = "hybrid_dilated_gla_macaron_block"


def rms_norm(x, g):
    xf = x.astype(jnp.float32)
    y = xf * lax.rsqrt(jnp.mean(xf * xf, axis=-1, keepdims=True) + RMS_EPS)
    return (y * g.astype(jnp.float32)).astype(x.dtype)


def swiglu(h, w_gate, w_up, w_down):
    return (jax.nn.silu(h @ w_gate) * (h @ w_up)) @ w_down


def partial_rope(t, positions):
    half = ROPE_DIM // 2
    inv = jnp.power(ROPE_THETA, -(jnp.arange(half, dtype=jnp.float32) * 2.0 / ROPE_DIM))
    ang = positions.astype(jnp.float32)[..., None] * inv
    cos = jnp.cos(ang)[:, :, None, :]
    sin = jnp.sin(ang)[:, :, None, :]
    t1 = t[..., :half].astype(jnp.float32)
    t2 = t[..., half:ROPE_DIM].astype(jnp.float32)
    rot = jnp.concatenate([t1 * cos - t2 * sin, t2 * cos + t1 * sin], axis=-1).astype(t.dtype)
    return jnp.concatenate([rot, t[..., ROPE_DIM:]], axis=-1)


def dilated_pattern(q, k, v, window, dilation):
    B, S_pad, H, dh = q.shape
    span = window // dilation
    M = S_pad // dilation
    nb = M // A_BLOCK

    def to_blocks(t):
        return t.reshape(B, M, dilation, H, dh).transpose(0, 2, 3, 1, 4).reshape(
            B, dilation, H, nb, A_BLOCK, dh)

    def with_prev(t):
        prev = jnp.pad(t[:, :, :, :-1], ((0, 0), (0, 0), (0, 0), (1, 0), (0, 0), (0, 0)))
        return jnp.concatenate([prev, t], axis=4)

    qb = to_blocks(q)
    kb = with_prev(to_blocks(k))
    vb = with_prev(to_blocks(v))
    s = jnp.einsum('brhnqe,brhnke->brhnqk', qb, kb).astype(jnp.float32) * (dh ** -0.5)
    qi = jnp.arange(A_BLOCK)[:, None]
    kj = jnp.arange(2 * A_BLOCK)[None, :]
    dist = qi + A_BLOCK - kj
    band = (dist >= 0) & (dist <= span)
    blk = jnp.arange(nb)[:, None, None]
    valid = band[None] & ((blk > 0) | (kj[None] >= A_BLOCK))
    s = jnp.where(valid, s, -jnp.inf)
    lse = jax.nn.logsumexp(s, axis=-1)
    p = jnp.exp(s - lse[..., None]).astype(v.dtype)
    o = jnp.einsum('brhnqk,brhnke->brhnqe', p, vb)
    o = o.reshape(B, dilation, H, M, dh).transpose(0, 3, 1, 2, 4).reshape(B, S_pad, H, dh)
    lse = lse.reshape(B, dilation, H, M).transpose(0, 3, 1, 2).reshape(B, S_pad, H)
    return o, lse


def dilated_attention(q, k, v):
    B, S, H, dh = q.shape
    unit = A_BLOCK * MAX_DILATION
    S_pad = -(-S // unit) * unit
    pad = ((0, 0), (0, S_pad - S), (0, 0), (0, 0))
    qp, kp, vp = jnp.pad(q, pad), jnp.pad(k, pad), jnp.pad(v, pad)
    outs, lses = [], []
    for window, dilation in DILATED_PATTERNS:
        o_i, lse_i = dilated_pattern(qp, kp, vp, window, dilation)
        outs.append(o_i)
        lses.append(lse_i)
    w = jax.nn.softmax(jnp.stack(lses, axis=0), axis=0)
    o = jnp.sum(w[..., None] * jnp.stack(outs, axis=0).astype(jnp.float32), axis=0)
    return o[:, :S].astype(q.dtype)


def gla_chunked(q, k, v, log_a):
    out_dtype = v.dtype
    B, S, H, dk = q.shape
    dv = v.shape[-1]
    C, Cs = GLA_CHUNK, GLA_SUB
    NS = C // Cs
    n = S // C

    def chunks(t):
        return t.astype(jnp.float32).reshape(B, n, C, H, t.shape[-1]).transpose(0, 3, 1, 2, 4)

    q, k, v, g = chunks(q), chunks(k), chunks(v), chunks(log_a)
    b = jnp.cumsum(g, axis=3)
    b_last = b[:, :, :, -1]
    k_to_end = k * jnp.exp(b_last[:, :, :, None] - b)
    upd = jnp.einsum('bhncd,bhnce->bhnde', k_to_end, v)

    def step(state, inp):
        decay, u = inp
        return decay[..., None] * state + u, state

    s0 = jnp.zeros((B, H, dk, dv), jnp.float32)
    _, s_prev = lax.scan(step, s0, (jnp.moveaxis(jnp.exp(b_last), 2, 0), jnp.moveaxis(upd, 2, 0)))
    s_prev = jnp.moveaxis(s_prev, 0, 2)
    o_inter = jnp.einsum('bhncd,bhnde->bhnce', q * jnp.exp(b), s_prev)
    qs = q.reshape(B, H, n, NS, Cs, dk)
    ksub = k.reshape(B, H, n, NS, Cs, dk)
    vs = v.reshape(B, H, n, NS, Cs, dv)
    bs = b.reshape(B, H, n, NS, Cs, dk)
    ref = jnp.concatenate([jnp.zeros_like(bs[:, :, :, :1, 0]), bs[:, :, :, :-1, -1]], axis=3)
    q_ref = qs * jnp.exp(bs - ref[:, :, :, :, None])
    k_ref = k[:, :, :, None] * jnp.exp(jnp.minimum(ref[:, :, :, :, None] - b[:, :, :, None], 0.0))
    a_cross = jnp.einsum('bhnsid,bhnsjd->bhnsij', q_ref, k_ref)
    cross_mask = jnp.arange(C)[None, None, :] < (jnp.arange(NS) * Cs)[:, None, None]
    a_cross = jnp.where(cross_mask, a_cross, 0.0)
    o_cross = jnp.einsum('bhnsij,bhnje->bhnsie', a_cross, v)
    tri = jnp.tril(jnp.ones((Cs, Cs), dtype=bool))
    diff = bs[:, :, :, :, :, None, :] - bs[:, :, :, :, None, :, :]
    decay = jnp.exp(jnp.where(tri[:, :, None], diff, -jnp.inf))
    a_diag = jnp.einsum('bhnsid,bhnsjd,bhnsijd->bhnsij', qs, ksub, decay)
    o_diag = jnp.einsum('bhnsij,bhnsje->bhnsie', a_diag, vs)
    o = o_inter + (o_cross + o_diag).reshape(B, H, n, C, dv)
    return o.transpose(0, 2, 3, 1, 4).reshape(B, S, H, dv).astype(out_dtype)


def setup_inputs(seed: int = 0) -> dict:
    key = jax.random.key(seed)
    ks = jax.random.split(key, 21)
    f32 = jnp.float32
    L = DEPTH

    def dense(k, shape, fan_in):
        return jax.random.normal(k, shape, f32) * (fan_in ** -0.5)

    def gain(k, dim):
        return 1.0 + 0.02 * jax.random.normal(k, (L, dim), f32)

    return {
        "x": jax.random.normal(ks[0], (BATCH, SEQ, D_MODEL), f32),
        "positions": jnp.broadcast_to(jnp.arange(SEQ, dtype=jnp.int32), (BATCH, SEQ)),
        "ffn1_norm": gain(ks[1], D_MODEL),
        "ffn1_w_gate": dense(ks[2], (L, D_MODEL, D_FF), D_MODEL),
        "ffn1_w_up": dense(ks[3], (L, D_MODEL, D_FF), D_MODEL),
        "ffn1_w_down": dense(ks[4], (L, D_FF, D_MODEL), D_FF),
        "mix_norm": gain(ks[5], D_MODEL),
        "w_in": dense(ks[6], (L, D_MODEL, IN_WIDTH), D_MODEL),
        "a_q_norm": gain(ks[7], A_HEAD_DIM),
        "a_k_norm": gain(ks[8], A_HEAD_DIM),
        "b_gate_w2": dense(ks[9], (L, GATE_RANK, B_KEY_WIDTH), GATE_RANK),
        "b_gate_bias": 0.1 * jax.random.normal(ks[10], (L, B_KEY_WIDTH), f32),
        "b_out_norm": gain(ks[11], B_VAL_DIM),
        "w_a_up": dense(ks[12], (L, A_WIDTH, D_MODEL), A_WIDTH),
        "w_b_up": dense(ks[13], (L, B_VAL_WIDTH, D_MODEL), B_VAL_WIDTH),
        "w_out": dense(ks[14], (L, D_MODEL, D_MODEL), D_MODEL),
        "ffn2_norm": gain(ks[15], D_MODEL),
        "ffn2_w_gate": dense(ks[16], (L, D_MODEL, D_FF), D_MODEL),
        "ffn2_w_up": dense(ks[17], (L, D_MODEL, D_FF), D_MODEL),
        "ffn2_w_down": dense(ks[18], (L, D_FF, D_MODEL), D_FF),
    }


def reference(x, positions, ffn1_norm, ffn1_w_gate, ffn1_w_up, ffn1_w_down,
              mix_norm, w_in, a_q_norm, a_k_norm, b_gate_w2, b_gate_bias, b_out_norm,
              w_a_up, w_b_up, w_out, ffn2_norm, ffn2_w_gate, ffn2_w_up, ffn2_w_down):
    B, S, _ = x.shape
    split_points = np.cumsum(IN_SPLITS)[:-1].tolist()
    for l in range(DEPTH):
        x = x + 0.5 * swiglu(rms_norm(x, ffn1_norm[l]), ffn1_w_gate[l], ffn1_w_up[l], ffn1_w_down[l])
        h = rms_norm(x, mix_norm[l])
        proj = h @ w_in[l]
        aq, ak, av, bq, bk, bv, br, bz, ga, gb = jnp.split(proj, split_points, axis=-1)
        aq = partial_rope(rms_norm(aq.reshape(B, S, A_HEADS, A_HEAD_DIM), a_q_norm[l]), positions)
        ak = partial_rope(rms_norm(ak.reshape(B, S, A_HEADS, A_HEAD_DIM), a_k_norm[l]), positions)
        av = av.reshape(B, S, A_HEADS, A_HEAD_DIM)
        o_a = dilated_attention(aq, ak, av).reshape(B, S, A_WIDTH)
        log_a = jax.nn.log_sigmoid((bz @ b_gate_w2[l] + b_gate_bias[l]).astype(jnp.float32)) / GATE_NORMALIZER
        o_b = gla_chunked(bq.reshape(B, S, B_HEADS, B_KEY_DIM) * (B_KEY_DIM ** -0.5),
                          bk.reshape(B, S, B_HEADS, B_KEY_DIM),
                          bv.reshape(B, S, B_HEADS, B_VAL_DIM),
                          log_a.reshape(B, S, B_HEADS, B_KEY_DIM))
        o_b = rms_norm(o_b, b_out_norm[l]).reshape(B, S, B_VAL_WIDTH) * jax.nn.silu(br)
        y = jax.nn.sigmoid(ga) * (o_a @ w_a_up[l]) + jax.nn.sigmoid(gb) * (o_b @ w_b_up[l])
        x = x + y @ w_out[l]
        x = x + 0.5 * swiglu(rms_norm(x, ffn2_norm[l]), ffn2_w_gate[l], ffn2_w_up[l], ffn2_w_down[l])
    return x
```

```cpp
#include <hip/hip_runtime.h>
#include <hip/hip_cooperative_groups.h>
#include <cstdio>
#include <cstdint>
namespace cg = cooperative_groups;

#define LAS __attribute__((address_space(3)))
typedef unsigned short bf16_t;
typedef short bf16x8 __attribute__((ext_vector_type(8)));
typedef float f32x4 __attribute__((ext_vector_type(4)));
typedef float f32x2 __attribute__((ext_vector_type(2)));
typedef unsigned u32x4 __attribute__((ext_vector_type(4)));
typedef unsigned u32x2 __attribute__((ext_vector_type(2)));

constexpr int M = 16384, D = 2048, FF = 5632;
constexpr int NPROJ = 10240;
constexpr int AW = 1024;
constexpr float RMS_EPS = 1e-6f;
constexpr int NWAVES = 8;

constexpr size_t MiB = 1u << 20;
constexpr size_t WS_BAR = 768 * 1024;
constexpr size_t WS_BZ = 1 * MiB;
constexpr size_t WS_WGU = 2 * MiB;
constexpr size_t WS_WD = 46 * MiB;
constexpr size_t WS_ORAW = 2 * MiB;
constexpr size_t WS_Y = 2 * MiB;
constexpr size_t WS_WIN = 68 * MiB;
constexpr size_t WS_SLOC = 68 * MiB;
constexpr size_t WS_DG = 100 * MiB;
constexpr size_t WS_WUPA = 108 * MiB, WS_WUPB = 112 * MiB;
constexpr size_t WS_WOUT = 116 * MiB;
constexpr size_t WS_H = 124 * MiB;
constexpr size_t WS_QKVA = 188 * MiB;
constexpr size_t WS_BB = 284 * MiB;
constexpr size_t WS_GATES = 380 * MiB;
constexpr size_t WS_ACT = 188 * MiB;
constexpr size_t WS_T = 188 * MiB;
constexpr size_t WS_X2B = 380 * MiB;
constexpr size_t WS_END = 508 * MiB;

constexpr int LDS_BYTES = 147456;

__device__ __forceinline__ unsigned f2bf(float f) { unsigned u = __builtin_bit_cast(unsigned, f); return (u + 0x7fffu + ((u >> 16) & 1u)) >> 16; }
__device__ __forceinline__ unsigned pk2(float lo, float hi) { return f2bf(lo) | (f2bf(hi) << 16); }
__device__ __forceinline__ float bf2f(unsigned short b) { return __builtin_bit_cast(float, (unsigned)b << 16); }
__device__ __forceinline__ float bflo(unsigned w) { return __builtin_bit_cast(float, w << 16); }
__device__ __forceinline__ float bfhi(unsigned w) { return __builtin_bit_cast(float, w & 0xffff0000u); }
__device__ __forceinline__ float wave_sum(float v) {
#pragma unroll
    for (int o = 1; o < 64; o <<= 1) v += __shfl_xor(v, o);
    return v;
}
__device__ __forceinline__ float wave_max(float v) {
#pragma unroll
    for (int o = 1; o < 64; o <<= 1) v = fmaxf(v, __shfl_xor(v, o));
    return v;
}
__device__ __forceinline__ float sigmoidf_(float x) { return __builtin_amdgcn_rcpf(1.0f + __builtin_amdgcn_exp2f(-1.44269504089f * x)); }

namespace pg8 {
constexpr int BM = 256, BK = 64, HALF = 128, HTB = HALF * BK * 2, STAGE_BYTES = 8 * HTB, NXCD = 8;
__host__ __device__ __forceinline__ int lds_byte(int r, int c) { const int st = (r >> 4) * 2 + (c >> 5), rr = r & 15, cc = c & 31, ob = rr * 64 + cc * 2; return st * 1024 + (ob ^ (((ob >> 9) & 1) << 5)); }
__host__ __device__ __forceinline__ void stage_rc(int b, int& R, int& C) { const int st = b / 1024, sb = b % 1024, swz = sb ^ (((sb >> 9) & 1) << 5); R = (st >> 1) * 16 + swz / 64; C = (st & 1) * 32 + (swz % 64) / 2; }
__host__ __device__ __forceinline__ int perm32(int rho) { const int n = rho >> 4, i = rho & 15; return 8 * (i >> 2) + 4 * n + (i & 3); }

struct Unit { int pm, pn; };
struct Gemm { const bf16_t* A; const bf16_t* Bt; int M, N, K, lda, ldb; };

struct StaticOrder {
    int nM, nN, nwg, G, c, WGM;
    __host__ __device__ void init(int M_, int N_, int G_, int c_, int wgm = 8) { nM = M_ / BM; nN = N_ / BM; nwg = nM * nN; G = G_; c = c_; WGM = wgm; }
    __host__ __device__ bool next(int i, Unit& u) const {
        const long L = (long)i * G + c; if (L >= nwg) return false;
        int wgid = (int)L; { const int q = nwg / NXCD, r = nwg % NXCD, xcd = wgid % NXCD, off = wgid / NXCD; wgid = (xcd < r ? xcd * (q + 1) : r * (q + 1) + (xcd - r) * q) + off; }
        const int nig = WGM * nN, gid = wgid / nig, fm = gid * WGM, gsz = (nM - fm) < WGM ? (nM - fm) : WGM;
        u.pm = fm + ((wgid % nig) % gsz); u.pn = (wgid % nig) / gsz; return true;
    }
};

__device__ __forceinline__ unsigned cvt_pk_bf16(float lo, float hi) { unsigned r; asm volatile("v_cvt_pk_bf16_f32 %0, %1, %2" : "=v"(r) : "v"(lo), "v"(hi)); return r; }

__device__ __forceinline__ float silu_(float g) { return g * __builtin_amdgcn_rcpf(1.0f + __builtin_amdgcn_exp2f(-1.44269504089f * g)); }
__device__ __forceinline__ f32x2 silu_mul_pk(f32x2 g, f32x2 u) {
    const f32x2 t = g * (-1.44269504089f);
    f32x2 e; e.x = __builtin_amdgcn_exp2f(t.x); e.y = __builtin_amdgcn_exp2f(t.y);
    const f32x2 dd = e + 1.0f;
    f32x2 r; r.x = __builtin_amdgcn_rcpf(dd.x); r.y = __builtin_amdgcn_rcpf(dd.y);
    return (g * r) * u;
}
__device__ __forceinline__ f32x2 sigmoid_pk(f32x2 g) {
    const f32x2 t = g * (-1.44269504089f);
    f32x2 e; e.x = __builtin_amdgcn_exp2f(t.x); e.y = __builtin_amdgcn_exp2f(t.y);
    const f32x2 dd = e + 1.0f;
    f32x2 r; r.x = __builtin_amdgcn_rcpf(dd.x); r.y = __builtin_amdgcn_rcpf(dd.y);
    return r;
}

struct EpiSwiGLU {
    static constexpr bool PERM = true;
    bf16_t* O; int ldc;
    __device__ __forceinline__ void operator()(const f32x4 (&acc)[2][2][4][2], const Unit& u, int wr, int wc, int fr, int fq) const {
        const int row0 = u.pm * BM + wr * 64 + fr; const int col0 = u.pn * HALF + wc * 32 + 8 * fq;
#pragma unroll
        for (int ai = 0; ai < 2; ++ai)
#pragma unroll
            for (int m = 0; m < 4; ++m) {
                bf16_t* rowp = O + (size_t)(row0 + ai * HALF + m * 16) * ldc + col0;
                const f32x4 g0 = acc[ai][0][m][0], g1 = acc[ai][0][m][1], u0 = acc[ai][1][m][0], u1 = acc[ai][1][m][1];
                const f32x2 a = silu_mul_pk((f32x2){g0[0], g0[1]}, (f32x2){u0[0], u0[1]}), b = silu_mul_pk((f32x2){g0[2], g0[3]}, (f32x2){u0[2], u0[3]});
                const f32x2 c = silu_mul_pk((f32x2){g1[0], g1[1]}, (f32x2){u1[0], u1[1]}), d = silu_mul_pk((f32x2){g1[2], g1[3]}, (f32x2){u1[2], u1[3]});
                u32x4 w; w.x = cvt_pk_bf16(a.x, a.y); w.y = cvt_pk_bf16(b.x, b.y); w.z = cvt_pk_bf16(c.x, c.y); w.w = cvt_pk_bf16(d.x, d.y);
                *(u32x4*)rowp = w;
            }
    }
};
struct EpiResid {
    static constexpr bool PERM = false;
    const float* base; float* out; int ldc; float scale;
    __device__ __forceinline__ void operator()(const f32x4 (&acc)[2][2][4][2], const Unit& u, int wr, int wc, int fr, int fq) const {
        const int col0 = u.pn * BM + wc * 32 + 4 * fq;
#pragma unroll
        for (int ai = 0; ai < 2; ++ai) {
            f32x4 pre[4][2][2];
#pragma unroll
            for (int m = 0; m < 4; ++m) {
                const size_t off = (size_t)(u.pm * BM + ai * HALF + wr * 64 + m * 16 + fr) * ldc + col0;
#pragma unroll
                for (int bj = 0; bj < 2; ++bj)
#pragma unroll
                    for (int n = 0; n < 2; ++n) pre[m][bj][n] = *(const f32x4*)(base + off + bj * HALF + n * 16);
            }
#pragma unroll
            for (int m = 0; m < 4; ++m) {
                const size_t off = (size_t)(u.pm * BM + ai * HALF + wr * 64 + m * 16 + fr) * ldc + col0;
#pragma unroll
                for (int bj = 0; bj < 2; ++bj)
#pragma unroll
                    for (int n = 0; n < 2; ++n) *(f32x4*)(out + off + bj * HALF + n * 16) = pre[m][bj][n] + acc[ai][bj][m][n] * scale;
            }
        }
    }
};
template <bool IN_F32, bool OUT_F32> struct EpiResidX {
    static constexpr bool PERM = true;
    const void* base; void* out; float scale;
    __device__ __forceinline__ void operator()(const f32x4 (&acc)[2][2][4][2], const Unit& u, int wr, int wc, int fr, int fq) const {
        const int row0 = u.pm * BM + wr * 64 + fr; const int col0 = u.pn * BM + wc * 32 + 8 * fq;
#pragma unroll
        for (int ai = 0; ai < 2; ++ai) {
            f32x4 p0[4][2], p1[4][2];
#pragma unroll
            for (int m = 0; m < 4; ++m)
#pragma unroll
                for (int bj = 0; bj < 2; ++bj) {
                    const size_t e = (size_t)(row0 + ai * HALF + m * 16) * 2048 + col0 + bj * HALF;
                    if (IN_F32) { p0[m][bj] = *(const f32x4*)((const float*)base + e); p1[m][bj] = *(const f32x4*)((const float*)base + e + 4); }
                    else { const u32x4 w = *(const u32x4*)((const bf16_t*)base + e); p0[m][bj] = (f32x4){bflo(w.x), bfhi(w.x), bflo(w.y), bfhi(w.y)}; p1[m][bj] = (f32x4){bflo(w.z), bfhi(w.z), bflo(w.w), bfhi(w.w)}; }
                }
#pragma unroll
            for (int m = 0; m < 4; ++m)
#pragma unroll
                for (int bj = 0; bj < 2; ++bj) {
                    const size_t e = (size_t)(row0 + ai * HALF + m * 16) * 2048 + col0 + bj * HALF;
                    const f32x4 v0 = p0[m][bj] + acc[ai][bj][m][0] * scale, v1 = p1[m][bj] + acc[ai][bj][m][1] * scale;
                    if (OUT_F32) { *(f32x4*)((float*)out + e) = v0; *(f32x4*)((float*)out + e + 4) = v1; }
                    else { u32x4 w; w.x = cvt_pk_bf16(v0[0], v0[1]); w.y = cvt_pk_bf16(v0[2], v0[3]); w.z = cvt_pk_bf16(v1[0], v1[1]); w.w = cvt_pk_bf16(v1[2], v1[3]); *(u32x4*)((bf16_t*)out + e) = w; }
                }
        }
    }
};
__device__ __forceinline__ unsigned qbyte(float sgm) { const float t = fminf(sgm * 256.0f, 255.0f); return (unsigned)t; }
__device__ __forceinline__ float ubyte(unsigned w, int k) { return (float)((w >> (8 * k)) & 0xffu); }
struct EpiProj {
    static constexpr bool PERM = true;
    bf16_t* qkva; bf16_t* bb; unsigned char* gates;
    __device__ __forceinline__ void operator()(const f32x4 (&acc)[2][2][4][2], const Unit& u, int wr, int wc, int fr, int fq) const {
        bf16_t* base = qkva; int ldc = 3072, colt; bool sg = false;
        if (u.pn < 12) { colt = u.pn * BM; } else if (u.pn < 24) { base = bb; colt = (u.pn - 12) * BM; } else { colt = (u.pn - 24) * BM; sg = true; }
        const int row0 = u.pm * BM + wr * 64 + fr; const int col0 = colt + wc * 32 + 8 * fq;
#pragma unroll
        for (int ai = 0; ai < 2; ++ai)
#pragma unroll
            for (int m = 0; m < 4; ++m) {
                bf16_t* rowp = base + (size_t)(row0 + ai * HALF + m * 16) * ldc + col0;
#pragma unroll
                for (int bj = 0; bj < 2; ++bj) {
                    f32x4 v0 = acc[ai][bj][m][0], v1 = acc[ai][bj][m][1];
                    if (sg) {
                        const f32x2 a = sigmoid_pk((f32x2){v0[0], v0[1]}), b = sigmoid_pk((f32x2){v0[2], v0[3]}), c = sigmoid_pk((f32x2){v1[0], v1[1]}), d = sigmoid_pk((f32x2){v1[2], v1[3]});
                        u32x2 qw;
                        qw.x = qbyte(a.x) | (qbyte(a.y) << 8) | (qbyte(b.x) << 16) | (qbyte(b.y) << 24);
                        qw.y = qbyte(c.x) | (qbyte(c.y) << 8) | (qbyte(d.x) << 16) | (qbyte(d.y) << 24);
                        *(u32x2*)(gates + (size_t)(row0 + ai * HALF + m * 16) * 4096 + col0 + bj * HALF) = qw;
                        continue;
                    }
                    u32x4 w; w.x = cvt_pk_bf16(v0[0], v0[1]); w.y = cvt_pk_bf16(v0[2], v0[3]); w.z = cvt_pk_bf16(v1[0], v1[1]); w.w = cvt_pk_bf16(v1[2], v1[3]);
                    *(u32x4*)(rowp + bj * HALF) = w;
                }
            }
    }
};
struct NoHook { static constexpr int AT = -1; __device__ __forceinline__ void operator()(f32x4 (&)[2][2][4][2], const Unit&, int, int, int, int) const {} };
struct GateMid {
    static constexpr int AT = 16;
    const unsigned char* G;
    __device__ __forceinline__ void operator()(f32x4 (&acc)[2][2][4][2], const Unit& u, int wr, int wc, int fr, int fq) const {
        asm volatile("" : "+v"(fr), "+v"(fq));
        const int row0 = u.pm * BM + wr * 64 + fr; const int col0 = u.pn * BM + wc * 32 + 8 * fq;
        const unsigned char* gp = G + (size_t)row0 * 4096 + col0;
#pragma unroll
        for (int ai = 0; ai < 2; ++ai) {
            u32x2 ga[4][2], gb[4][2];
#pragma unroll
            for (int m = 0; m < 4; ++m)
#pragma unroll
                for (int bj = 0; bj < 2; ++bj) { const unsigned r = (unsigned)(ai * HALF + m * 16) * 4096u; ga[m][bj] = *(const u32x2*)(gp + r + bj * HALF); gb[m][bj] = *(const u32x2*)(gp + r + 2048 + bj * HALF); }
            asm volatile("" ::: "memory");
#pragma unroll
            for (int m = 0; m < 4; ++m)
#pragma unroll
                for (int bj = 0; bj < 2; ++bj) {
                    const u32x2 a = ga[m][bj], b = gb[m][bj];
                    f32x4 v0 = acc[ai][bj][m][0], v1 = acc[ai][bj][m][1];
#pragma unroll
                    for (int k = 0; k < 4; ++k) {
                        v0[k] *= (ubyte(a.x, k) + 0.5f) * __builtin_amdgcn_rcpf(ubyte(b.x, k) + 0.5f);
                        v1[k] *= (ubyte(a.y, k) + 0.5f) * __builtin_amdgcn_rcpf(ubyte(b.y, k) + 0.5f);
                    }
                    acc[ai][bj][m][0] = v0; acc[ai][bj][m][1] = v1;
                }
            asm volatile("" ::: "memory");
        }
    }
};
struct EpiGateY {
    static constexpr bool PERM = true;
    const unsigned char* G; bf16_t* Y;
    __device__ __forceinline__ void operator()(const f32x4 (&acc)[2][2][4][2], const Unit& u, int wr, int wc, int fr, int fq) const {
        const int row0 = u.pm * BM + wr * 64 + fr; const int col0 = u.pn * BM + wc * 32 + 8 * fq;
#pragma unroll
        for (int ai = 0; ai < 2; ++ai) {
            u32x2 gpre[4][2];
#pragma unroll
            for (int m = 0; m < 4; ++m)
#pragma unroll
                for (int bj = 0; bj < 2; ++bj) gpre[m][bj] = *(const u32x2*)(G + (size_t)(row0 + ai * HALF + m * 16) * 4096 + 2048 + col0 + bj * HALF);
#pragma unroll
            for (int m = 0; m < 4; ++m) {
                const size_t r = (size_t)(row0 + ai * HALF + m * 16);
#pragma unroll
                for (int bj = 0; bj < 2; ++bj) {
                    const u32x2 g = gpre[m][bj];
                    f32x4 v0 = acc[ai][bj][m][0], v1 = acc[ai][bj][m][1];
#pragma unroll
                    for (int k = 0; k < 4; ++k) { v0[k] *= (ubyte(g.x, k) + 0.5f) * (1.0f / 256.0f); v1[k] *= (ubyte(g.y, k) + 0.5f) * (1.0f / 256.0f); }
                    u32x4 w; w.x = cvt_pk_bf16(v0[0], v0[1]); w.y = cvt_pk_bf16(v0[2], v0[3]); w.z = cvt_pk_bf16(v1[0], v1[1]); w.w = cvt_pk_bf16(v1[2], v1[3]);
                    *(u32x4*)(Y + r * 2048 + col0 + bj * HALF) = w;
                }
            }
        }
    }
};

template <class Epi, bool ALIGN_EPI, class Hook = NoHook>
__device__ __forceinline__ void gemm_phase(LAS unsigned char* lds, const Gemm g, const StaticOrder& S, const Epi& E, const Hook& HK = Hook()) {
    int tid = threadIdx.x; asm volatile("" : "+v"(tid));
    const int wid = __builtin_amdgcn_readfirstlane(tid >> 6), lane = tid & 63, wr = wid >> 2, wc = wid & 3, fr = lane & 15, fq = lane >> 4;
    const int K = g.K, nt = K / BK;
    unsigned voffA[2], voffB[2];
#pragma unroll
    for (int i = 0; i < 2; ++i) { int R, C; stage_rc(tid * 16 + i * 8192, R, C); const int Rb = Epi::PERM ? ((R & ~31) + perm32(R & 31)) : R;
        voffA[i] = (unsigned)(R * g.lda + C) * 2u; voffB[i] = (unsigned)(Rb * g.ldb + C) * 2u; }
    const size_t kstep = (size_t)(BK * 2);
    const size_t hstepA = (size_t)HALF * g.lda * 2, hstepB = (size_t)HALF * g.ldb * 2;
    const size_t tstepA = 2 * hstepA, tstepB = 2 * hstepB;
    const unsigned ldsw = (unsigned)wid * 1024u;
    const int aoff = lds_byte(wr * 64 + fr, fq * 8), boff = lds_byte(wc * 32 + fr, fq * 8);
#define PG8_SA(b, h) (((b) * 2 + (h)) * HTB)
#define PG8_SB(b, h) ((4 + (b) * 2 + (h)) * HTB)
#define PG8_STAGE(bufoff, gbase, voff) do { _Pragma("unroll") for (int _i = 0; _i < 2; ++_i) \
        __builtin_amdgcn_global_load_lds((const unsigned*)((const char*)(gbase) + (voff)[_i]), (LAS unsigned*)(lds + (bufoff) + ldsw + _i * 8192), 16, 0, 0); } while (0)
#define PG8_LDA(dst, b, h) do { _Pragma("unroll") for (int m = 0; m < 4; ++m) _Pragma("unroll") for (int k = 0; k < 2; ++k) dst[m][k] = *(const LAS bf16x8*)(lds + PG8_SA(b, h) + aoff + m * 2048 + k * 1024); } while (0)
#define PG8_LDB(dst, b, h) do { _Pragma("unroll") for (int n = 0; n < 2; ++n) _Pragma("unroll") for (int k = 0; k < 2; ++k) dst[n][k] = *(const LAS bf16x8*)(lds + PG8_SB(b, h) + boff + n * 2048 + k * 1024); } while (0)
#define PG8_MMA(ai, bj, At, Bt) do { __builtin_amdgcn_s_setprio(1); _Pragma("unroll") for (int m = 0; m < 4; ++m) _Pragma("unroll") for (int n = 0; n < 2; ++n) _Pragma("unroll") for (int k = 0; k < 2; ++k) \
        acc[ai][bj][m][n] = __builtin_amdgcn_mfma_f32_16x16x32_bf16(Bt[n][k], At[m][k], acc[ai][bj][m][n], 0, 0, 0); __builtin_amdgcn_s_setprio(0); } while (0)
#define PG8_WAIT_V(n) asm volatile("s_waitcnt vmcnt(" #n ")" ::: "memory")
#define PG8_WAIT_L(n) asm volatile("s_waitcnt lgkmcnt(" #n ")" ::: "memory")
#define PG8_BAR __builtin_amdgcn_s_barrier()
#define PG8_SCHED __builtin_amdgcn_sched_barrier(0)
    Unit cur, nxt; int ui = 0;
    if (!S.next(0, cur)) return;
    f32x4 acc[2][2][4][2];
#pragma unroll
    for (int a = 0; a < 2; ++a)
#pragma unroll
        for (int b = 0; b < 2; ++b)
#pragma unroll
            for (int m = 0; m < 4; ++m)
#pragma unroll
                for (int n = 0; n < 2; ++n) acc[a][b][m][n] = (f32x4){0.f, 0.f, 0.f, 0.f};
    bf16x8 At[4][2], B0[2][2], B1[2][2];
    const char* cA = (const char*)g.A + (size_t)cur.pm * tstepA; const char* cB = (const char*)g.Bt + (size_t)cur.pn * tstepB;
    PG8_STAGE(PG8_SB(0, 0), cB, voffB); PG8_STAGE(PG8_SB(0, 1), cB + hstepB, voffB); PG8_STAGE(PG8_SA(0, 0), cA, voffA); PG8_STAGE(PG8_SA(0, 1), cA + hstepA, voffA);
    if (wr == 1) PG8_BAR;
    PG8_WAIT_V(2); PG8_BAR;
    PG8_STAGE(PG8_SB(1, 0), cB + kstep, voffB); PG8_STAGE(PG8_SA(1, 0), cA + kstep, voffA); PG8_STAGE(PG8_SB(1, 1), cB + hstepB + kstep, voffB);
    PG8_WAIT_V(6); PG8_BAR;
    for (;;) {
        const bool has_next = S.next(ui + 1, nxt);
        const char* nA = has_next ? (const char*)g.A + (size_t)nxt.pm * tstepA : cA; const char* nB = has_next ? (const char*)g.Bt + (size_t)nxt.pn * tstepB : cB;
        for (int t = 0; t < nt; t += 2) {
            if (Hook::AT > 0 && t == Hook::AT) HK(acc, cur, wr, wc, fr, fq);
            const bool last = (t == nt - 2);
            const char* a1 = cA + (size_t)(t + 1) * kstep;
            const char* a2 = last ? nA : cA + (size_t)(t + 2) * kstep; const char* b2 = last ? nB : cB + (size_t)(t + 2) * kstep;
            const char* a3 = a2 + kstep; const char* b3 = b2 + kstep;
            PG8_LDB(B0, 0, 0); PG8_LDB(B1, 0, 1); PG8_SCHED; PG8_LDA(At, 0, 0); PG8_STAGE(PG8_SA(1, 1), a1 + hstepA, voffA);
            PG8_WAIT_V(8); PG8_WAIT_L(0); PG8_BAR; PG8_MMA(0, 0, At, B0); PG8_MMA(0, 1, At, B1); PG8_BAR; PG8_SCHED;
            PG8_LDA(At, 0, 1); PG8_STAGE(PG8_SB(0, 0), b2, voffB); PG8_STAGE(PG8_SB(0, 1), b2 + hstepB, voffB); PG8_STAGE(PG8_SA(0, 0), a2, voffA);
            PG8_WAIT_V(8); PG8_WAIT_L(0); PG8_BAR; PG8_MMA(1, 0, At, B0); PG8_MMA(1, 1, At, B1); PG8_BAR; PG8_SCHED;
            PG8_LDB(B0, 1, 0); PG8_LDB(B1, 1, 1); PG8_SCHED; PG8_LDA(At, 1, 0); PG8_STAGE(PG8_SA(0, 1), a2 + hstepA, voffA);
            PG8_WAIT_V(8); PG8_WAIT_L(0); PG8_BAR; PG8_MMA(0, 0, At, B0); PG8_MMA(0, 1, At, B1); PG8_BAR; PG8_SCHED;
            PG8_LDA(At, 1, 1); PG8_STAGE(PG8_SB(1, 0), b3, voffB); PG8_STAGE(PG8_SB(1, 1), b3 + hstepB, voffB); PG8_STAGE(PG8_SA(1, 0), a3, voffA);
            PG8_WAIT_V(8); PG8_WAIT_L(0); PG8_BAR; PG8_MMA(1, 0, At, B0); PG8_MMA(1, 1, At, B1); PG8_BAR; PG8_SCHED;
        }
        if constexpr (ALIGN_EPI) { if (wr == 0) PG8_BAR; }
        E(acc, cur, wr, wc, fr, fq);
        if (!has_next) break;
#pragma unroll
        for (int a = 0; a < 2; ++a)
#pragma unroll
            for (int b = 0; b < 2; ++b)
#pragma unroll
                for (int m = 0; m < 4; ++m)
#pragma unroll
                    for (int n = 0; n < 2; ++n) acc[a][b][m][n] = (f32x4){0.f, 0.f, 0.f, 0.f};
        cur = nxt; cA = nA; cB = nB; ++ui;
        if constexpr (ALIGN_EPI) { if (wr == 1) PG8_BAR; }
    }
    PG8_WAIT_V(0);
    if constexpr (!ALIGN_EPI) { if (wr == 0) PG8_BAR; }
    PG8_BAR;
#undef PG8_SA
#undef PG8_SB
#undef PG8_STAGE
#undef PG8_LDA
#undef PG8_LDB
#undef PG8_MMA
#undef PG8_WAIT_V
#undef PG8_WAIT_L
#undef PG8_BAR
#undef PG8_SCHED
}
}


#define XB_TMO      128
#define XB_XCNT(j)  (256  + 64 * (j))
#define XB_XSUB(j)  (1280 + 64 * (j))
#define XB_XGEN(j)  (2304 + 64 * (j))
#define XB_TOP      3328
#define XB_TOPGEN   3392
#define XCD_BAR_WORDS 3456
#define XB_SPIN_CAP (1u << 20)
__device__ __forceinline__ unsigned xb_ld(unsigned* p)              { return __hip_atomic_load(p, __ATOMIC_RELAXED, __HIP_MEMORY_SCOPE_AGENT); }
__device__ __forceinline__ unsigned xb_add(unsigned* p, unsigned v) { return __hip_atomic_fetch_add(p, v, __ATOMIC_RELAXED, __HIP_MEMORY_SCOPE_AGENT); }
__device__ __forceinline__ unsigned xb_xcc_id() { return (unsigned)__builtin_amdgcn_s_getreg((3 << 11) | 20) & 0xFu; }
#define XB_SPIN(cond, bar) do { unsigned _sp = 0; while (cond) { __builtin_amdgcn_s_sleep(1); \
    if ((++_sp & 255u) == 0u) { if (xb_ld(&(bar)[XB_TMO])) break; if (_sp > XB_SPIN_CAP) { atomicAdd(&(bar)[XB_TMO], 1u); break; } } } } while (0)
struct XcdBarrier { unsigned* bar; unsigned x; volatile LAS unsigned* st; };
__device__ __forceinline__ XcdBarrier xcd_barrier_post(unsigned* bar, volatile LAS unsigned* st) {
    XcdBarrier b; b.bar = bar; b.x = xb_xcc_id(); b.st = st;
    if (threadIdx.x == 0) (void)xb_add(&bar[XB_XCNT(b.x)], 1u);
    return b;
}
__device__ __forceinline__ void xcd_barrier_complete(unsigned* bar, unsigned x, unsigned& nloc, unsigned& nx) {
    const unsigned G = gridDim.x * gridDim.y * gridDim.z;
    unsigned sum, cnt, mine, sp = 0u;
    for (;;) {
        sum = 0u; cnt = 0u; mine = 0u;
#pragma unroll
        for (unsigned j = 0; j < 16; ++j) { const unsigned c = xb_ld(&bar[XB_XCNT(j)]); sum += c; cnt += (c > 0u) ? 1u : 0u; mine = (j == x) ? c : mine; }
        if (sum == G) break;
        __builtin_amdgcn_s_sleep(1);
        if ((++sp & 255u) == 0u) { if (xb_ld(&bar[XB_TMO])) break; if (sp > XB_SPIN_CAP) { atomicAdd(&bar[XB_TMO], 1u); break; } }
    }
    nloc = mine > 0u ? mine : 1u; nx = cnt > 0u ? cnt : 1u;
}
__device__ __forceinline__ void xcd_barrier(const XcdBarrier& b) {
    asm volatile("s_waitcnt vmcnt(0)" ::: "memory");
    __syncthreads();
    if (threadIdx.x == 0) {
        unsigned* bar = b.bar;
        __builtin_amdgcn_s_waitcnt(0);
        unsigned nloc = b.st[0], nx = b.st[1];
        if (nloc == 0u) { xcd_barrier_complete(bar, b.x, nloc, nx); b.st[0] = nloc; b.st[1] = nx; }
        const unsigned old = xb_add(&bar[XB_XSUB(b.x)], 1u);
        const unsigned gen = old / nloc;
        if (old + 1u == (gen + 1u) * nloc) {
            __builtin_amdgcn_fence(__ATOMIC_RELEASE, "agent");
            asm volatile("s_waitcnt vmcnt(0)" ::: "memory");
            const unsigned og = xb_add(&bar[XB_TOP], 1u);
            const unsigned tg = og / nx;
            if (og + 1u == (tg + 1u) * nx) xb_add(&bar[XB_TOPGEN], 1u);
            else XB_SPIN(xb_ld(&bar[XB_TOPGEN]) == tg, bar);
            __builtin_amdgcn_fence(__ATOMIC_ACQUIRE, "agent");
            xb_add(&bar[XB_XGEN(b.x)], 1u);
            asm volatile("s_waitcnt vmcnt(0)" ::: "memory");
        } else {
            XB_SPIN(xb_ld(&bar[XB_XGEN(b.x)]) == gen, bar);
            __builtin_amdgcn_fence(__ATOMIC_ACQUIRE, "agent");
            asm volatile("s_waitcnt vmcnt(0)" ::: "memory");
        }
    }
    __syncthreads();
}

struct Args { const float* in[20]; float* out; unsigned char* ws; };

struct Frame {
    LAS unsigned char* lds;
    int tid, lane, wave, G, gw, NGW;
};

__device__ __forceinline__ void transpose_item(const float* W, int ldw, int ldt, bf16_t* WT, int src_col0, int dst_row0, int k0, LAS float* scr, int lane) {
    float v[32];
    const float* wp = W + (size_t)(k0 + (lane >> 5)) * ldw + src_col0 + (lane & 31);
#pragma unroll
    for (int i = 0; i < 32; ++i) v[i] = wp[(size_t)(2 * i) * ldw];
#pragma unroll
    for (int i = 0; i < 32; ++i) { const int kk = 2 * i + (lane >> 5); scr[kk * 33 + (lane & 31)] = v[i]; }
    asm volatile("s_waitcnt lgkmcnt(0)" ::: "memory");
    const int c = lane & 7;
#pragma unroll
    for (int j = 0; j < 4; ++j) { const int n = (lane >> 3) + 8 * j; const LAS float* s = scr + (8 * c) * 33 + n;
        u32x4 o; o.x = pk2(s[0 * 33], s[1 * 33]); o.y = pk2(s[2 * 33], s[3 * 33]); o.z = pk2(s[4 * 33], s[5 * 33]); o.w = pk2(s[6 * 33], s[7 * 33]);
        *(u32x4*)(WT + (size_t)(dst_row0 + n) * ldt + k0 + 8 * c) = o; }
    asm volatile("s_waitcnt lgkmcnt(0)" ::: "memory");
}
__device__ __forceinline__ void conv_matrix(const Frame& F, const float* W, int ldw, int K, int ncols_dst, int mode, bf16_t* WT, int rot, int ldt = 0) {
    if (ldt == 0) ldt = K;
    LAS float* scr = (LAS float*)(F.lds + F.wave * 16384);
    const int nblk = ncols_dst / 32, nitems = (K / 64) * nblk;
    int start = F.gw - rot; if (start < 0) start += F.NGW;
    for (int it = start; it < nitems; it += F.NGW) {
        const int kb = it / nblk, nb = it % nblk;
        int src = 32 * nb, dst = 32 * nb;
        if (mode == 1) dst = 256 * (nb >> 2) + 32 * (nb & 3);
        else if (mode == 2) dst = 256 * (nb >> 2) + 128 + 32 * (nb & 3);
        else if (mode == 3) src = 32 * nb + (32 * nb >= 6144 ? 16 : 0);
        transpose_item(W, ldw, ldt, WT, src, dst, 64 * kb, scr, F.lane);
    }
}

__device__ __forceinline__ void load_gain(const float* gain, int lane, f32x4 (&gv)[8]) {
#pragma unroll
    for (int j = 0; j < 8; ++j) gv[j] = ((const f32x4*)gain + lane)[64 * j];
}
__device__ __forceinline__ void rms_row(const float* xrow, const f32x4 (&gv)[8], bf16_t* orow, int lane, f32x4 (&hv)[8]) {
    const f32x4* xr = (const f32x4*)xrow + lane;
    float s = 0.f;
#pragma unroll
    for (int j = 0; j < 8; ++j) { hv[j] = xr[64 * j]; s += (hv[j].x * hv[j].x + hv[j].y * hv[j].y) + (hv[j].z * hv[j].z + hv[j].w * hv[j].w); }
    const float r = 1.0f / sqrtf(wave_sum(s) * (1.0f / D) + RMS_EPS);
    u32x2* o8 = (u32x2*)orow + lane;
#pragma unroll
    for (int j = 0; j < 8; ++j) { hv[j] = hv[j] * r * gv[j]; u32x2 w; w.x = pk2(hv[j].x, hv[j].y); w.y = pk2(hv[j].z, hv[j].w); o8[64 * j] = w; }
}

__device__ __forceinline__ void row_load(const bf16_t* xrow, int lane, f32x4 (&xv)[8]) {
    const u32x2* xr = (const u32x2*)xrow + lane;
#pragma unroll
    for (int j = 0; j < 8; ++j) { const u32x2 w = xr[64 * j]; xv[j] = (f32x4){bflo(w.x), bfhi(w.x), bflo(w.y), bfhi(w.y)}; }
}
__device__ __forceinline__ void row_load(const float* xrow, int lane, f32x4 (&xv)[8]) {
    const f32x4* xr = (const f32x4*)xrow + lane;
#pragma unroll
    for (int j = 0; j < 8; ++j) xv[j] = xr[64 * j];
}
__device__ __forceinline__ void row_finish(f32x4 (&xv)[8], const f32x4 (&gv)[8], bf16_t* orow, int lane) {
    float s = 0.f;
#pragma unroll
    for (int j = 0; j < 8; ++j) s += (xv[j].x * xv[j].x + xv[j].y * xv[j].y) + (xv[j].z * xv[j].z + xv[j].w * xv[j].w);
    const float r = 1.0f / sqrtf(wave_sum(s) * (1.0f / D) + RMS_EPS);
    u32x2* o8 = (u32x2*)orow + lane;
#pragma unroll
    for (int j = 0; j < 8; ++j) { xv[j] = xv[j] * r * gv[j]; u32x2 w; w.x = pk2(xv[j].x, xv[j].y); w.y = pk2(xv[j].z, xv[j].w); o8[64 * j] = w; }
}
template <class XT>
__device__ __forceinline__ void rms_rows_pipelined(const Frame& F, const XT* X, const float* gain, bf16_t* Hout) {
    f32x4 gv[8], xa[8], xb[8]; load_gain(gain, F.lane, gv);
    int m = F.gw;
    if (m < M) row_load(X + (size_t)m * D, F.lane, xa);
    for (; m < M; m += F.NGW) {
        const int mn = m + F.NGW;
        if (mn < M) row_load(X + (size_t)mn * D, F.lane, xb);
        row_finish(xa, gv, Hout + (size_t)m * D, F.lane);
#pragma unroll
        for (int j = 0; j < 8; ++j) xa[j] = xb[j];
    }
}

typedef short v4i16_t __attribute__((ext_vector_type(4)));
typedef float f32x2_t __attribute__((ext_vector_type(2))); typedef __bf16 bf16x2_t __attribute__((ext_vector_type(2)));
__device__ __forceinline__ unsigned cvtpk_s(float lo, float hi) { f32x2_t v = {lo, hi}; bf16x2_t b = __builtin_convertvector(v, bf16x2_t); return __builtin_bit_cast(unsigned, b); }
__device__ __forceinline__ v4i16_t vtr(const LAS unsigned char* p) { return __builtin_amdgcn_ds_read_tr16_b64_v4i16((LAS v4i16_t*)p); }
#define MFMA16(a, b, c) __builtin_amdgcn_mfma_f32_16x16x32_bf16((a), (b), (c), 0, 0, 0)

template <int PASS>
__device__ __forceinline__ void attn_pass(const Frame& F, const bf16_t* QKVA, bf16_t* OACC, float* LACC, bf16_t* Hout, float nb2) {
    constexpr int d = 1 << (2 * PASS);
    constexpr int KST = 272, VST = 288;
    LAS unsigned char* Kl = F.lds; LAS unsigned char* Vl = F.lds + 256 * KST;
    int lane = F.lane; asm volatile("" : "+v"(lane));
    const int w = F.wave, g = lane >> 4, c = lane & 15, q4 = c >> 2, p4 = c & 3;
    constexpr float SCL = 0.08838834764831845f * 1.44269504089f;
    u32x4 kpre[8], vpre[8]; bf16x8 qpre[4];
    auto issue = [&](int idx) {
        const int h = idx & 7, blk = idx >> 3, r = blk % d, n = blk / d;
        { const size_t tqn = (size_t)(n * 128 + 16 * w + c) * d + r;
#pragma unroll
          for (int kk = 0; kk < 4; ++kk) qpre[kk] = *(const bf16x8*)(QKVA + tqn * 3072 + h * 128 + 8 * g + 32 * kk); }
#pragma unroll
        for (int u = 0; u < 8; ++u) {
            const int e = F.tid + 512 * u, row = e >> 4, ch = e & 15;
            int mrow = (n - 1) * 128 + row; if (mrow < 0) mrow = 0;
            const size_t t = (size_t)mrow * d + r;
            kpre[u] = *(const u32x4*)(QKVA + t * 3072 + 1024 + h * 128 + ch * 8);
            vpre[u] = *(const u32x4*)(QKVA + t * 3072 + 2048 + h * 128 + ch * 8);
        }
    };
    if ((int)blockIdx.x < 1024) issue(blockIdx.x);
    for (int idx = blockIdx.x; idx < 1024; idx += F.G) {
        const int h = idx & 7, blk = idx >> 3, r = blk % d, n = blk / d;
        __syncthreads();
#pragma unroll
        for (int u = 0; u < 8; ++u) {
            const int e = F.tid + 512 * u, row = e >> 4, ch = e & 15;
            *(LAS u32x4*)(Kl + row * KST + ch * 16) = kpre[u];
            *(LAS u32x4*)(Vl + row * VST + ch * 16) = vpre[u];
        }
        __syncthreads();
        bf16x8 qf[4];
#pragma unroll
        for (int kk = 0; kk < 4; ++kk) qf[kk] = qpre[kk];
        if (idx + F.G < 1024) issue(idx + F.G);
        const int qi = 16 * w + c;
        const size_t tq = (size_t)(n * 128 + qi) * d + r;
        f32x4 accO[8];
        bf16_t* op = OACC + tq * 1024 + h * 128 + 4 * g;
        float lsum = 0.f;
        if (PASS > 0) {
#pragma unroll
            for (int nt = 0; nt < 8; ++nt) { const u32x2 pv = *(const u32x2*)(op + 16 * nt); accO[nt] = (f32x4){bflo(pv.x), bfhi(pv.x), bflo(pv.y), bfhi(pv.y)}; }
            lsum = (g == 0) ? LACC[tq * 8 + h] : 0.f;
        } else {
#pragma unroll
            for (int nt = 0; nt < 8; ++nt) accO[nt] = (f32x4){0.f, 0.f, 0.f, 0.f};
        }
#pragma unroll 1
        for (int ks = 0; ks < 5; ++ks) {
            u32x4 pw;
#pragma unroll
            for (int half = 0; half < 2; ++half) {
                const int kt = w + 2 * ks + half; const int ktc = kt < 16 ? kt : 15;
                f32x4 sv = (f32x4){0.f, 0.f, 0.f, 0.f};
#pragma unroll
                for (int kk = 0; kk < 4; ++kk) { const bf16x8 a = *(const LAS bf16x8*)(Kl + (16 * ktc + c) * KST + (8 * g + 32 * kk) * 2); sv = MFMA16(a, qf[kk], sv); }
                float pj[4];
#pragma unroll
                for (int j = 0; j < 4; ++j) { const int kj = 16 * kt + 4 * g + j; const bool valid = (kj >= qi) && (kj <= qi + 128) && (n > 0 || kj >= 128);
                    pj[j] = valid ? __builtin_amdgcn_exp2f(sv[j] * SCL + nb2) : 0.f; lsum += pj[j]; }
                if (half == 0) { pw.x = cvtpk_s(pj[0], pj[1]); pw.y = cvtpk_s(pj[2], pj[3]); } else { pw.z = cvtpk_s(pj[0], pj[1]); pw.w = cvtpk_s(pj[2], pj[3]); }
            }
            const bf16x8 pa = __builtin_bit_cast(bf16x8, pw);
            const int kt0 = w + 2 * ks, kt1 = (kt0 + 1 < 16) ? kt0 + 1 : 15;
            const LAS unsigned char* v0 = Vl + (16 * kt0 + 4 * g + q4) * VST + 8 * p4;
            const LAS unsigned char* v1 = Vl + (16 * kt1 + 4 * g + q4) * VST + 8 * p4;
#pragma unroll
            for (int nt = 0; nt < 8; ++nt) {
                const v4i16_t lo = vtr(v0 + 32 * nt), hi = vtr(v1 + 32 * nt);
                const bf16x8 vf = __builtin_shufflevector(lo, hi, 0, 1, 2, 3, 4, 5, 6, 7);
                accO[nt] = MFMA16(vf, pa, accO[nt]);
            }
        }
        lsum += __shfl_xor(lsum, 16); lsum += __shfl_xor(lsum, 32);
        if (PASS < 2) {
#pragma unroll
            for (int nt = 0; nt < 8; ++nt) { u32x2 o; o.x = cvtpk_s(accO[nt][0], accO[nt][1]); o.y = cvtpk_s(accO[nt][2], accO[nt][3]); *(u32x2*)(op + 16 * nt) = o; }
            if (g == 0) LACC[tq * 8 + h] = lsum;
        } else {
            const float il = 1.0f / lsum;
            bf16_t* hp = Hout + tq * 2048 + h * 128 + 4 * g;
#pragma unroll
            for (int nt = 0; nt < 8; ++nt) { u32x2 o; o.x = cvtpk_s(accO[nt][0] * il, accO[nt][1] * il); o.y = cvtpk_s(accO[nt][2] * il, accO[nt][3] * il); *(u32x2*)(hp + 16 * nt) = o; }
        }
    }
    __syncthreads();
}

constexpr int GL_QT = 0, GL_KH = 17408, GL_KE = 34816, GL_V = 53248, GL_AM = 88064, GL_BZ = 97280, GL_TOT = 101376, GL_EBL = 103424, GL_RED = 103936, GL_CS = 105984;
constexpr int GL_ST = 272, GL_KST = 288, GL_VST = 544, GL_AST = 144;
template <int MODE>
__device__ __forceinline__ void gla_item(const Frame& F, int hh, int grp, const bf16_t* BB, const float* BZ, const float* w2g, const float* biasg, const float* gn, float* SLOC, float* DG, bf16_t* Hout) {
    LAS unsigned char* L = F.lds;
    const int tid = F.tid, lane = F.lane, w = F.wave; int g = lane >> 4, c = lane & 15; asm volatile("" : "+v"(g), "+v"(c));
    const int q4 = c >> 2, p4 = c & 3;
    const int dd = tid & 127, qr = tid >> 7;
    f32x4 S[8][2];
    float* sbase = SLOC + ((size_t)(hh * 64 + grp) * 128) * 256;
#pragma unroll
    for (int mt = 0; mt < 8; ++mt)
#pragma unroll
        for (int nt = 0; nt < 2; ++nt) {
            if (MODE == 0) S[mt][nt] = (f32x4){0.f, 0.f, 0.f, 0.f};
            else {
                S[mt][nt] = *(const f32x4*)(sbase + (unsigned)((((mt * 2 + nt) * 8 + w) * 64 + (16 * g + c)) * 4));
            }
        }
    float w2r[16];
#pragma unroll
    for (int r = 0; r < 16; ++r) w2r[r] = w2g[r * 512 + hh * 128 + dd];
    const float bias = biasg[hh * 128 + dd];
    float lsum_d = 0.f;
#pragma unroll 1
    for (int ch = 0; ch < 4; ++ch) {
        const int t0 = (grp * 4 + ch) * 64;
        __syncthreads();
        float* Bg = (float*)Hout + (size_t)t0 * 1024 + 512 + hh * 128 + dd;
        float bpre[16]; float total = 0.f;
        if (MODE == 0) { if (tid < 256) *(LAS f32x4*)(L + GL_BZ + tid * 16) = *(const f32x4*)(BZ + (size_t)t0 * 16 + tid * 4); }
        else {
#pragma unroll
            for (int ii = 0; ii < 16; ++ii) bpre[ii] = Bg[(size_t)(16 * qr + ii) * 1024];
            total = Bg[(size_t)63 * 1024];
        }
        {
            u32x4 vv[4], kv[2], qv[2];
#pragma unroll
            for (int u = 0; u < 4; ++u) { const int e = tid + 512 * u, row = e >> 5, cc = e & 31; vv[u] = *(const u32x4*)(BB + (size_t)(t0 + row) * 3072 + 1024 + hh * 256 + cc * 8); }
#pragma unroll
            for (int u = 0; u < 2; ++u) { const int e = tid + 512 * u, row = e >> 4, cc = e & 15; kv[u] = *(const u32x4*)(BB + (size_t)(t0 + row) * 3072 + 512 + hh * 128 + cc * 8);
                if (MODE == 1) qv[u] = *(const u32x4*)(BB + (size_t)(t0 + row) * 3072 + hh * 128 + cc * 8); }
#pragma unroll
            for (int u = 0; u < 4; ++u) { const int e = tid + 512 * u, row = e >> 5, cc = e & 31; *(LAS u32x4*)(L + GL_V + row * GL_VST + cc * 16) = vv[u]; }
#pragma unroll
            for (int u = 0; u < 2; ++u) { const int e = tid + 512 * u, row = e >> 4, cc = e & 15; *(LAS u32x4*)(L + GL_KE + row * GL_KST + cc * 16) = kv[u];
                if (MODE == 1) *(LAS u32x4*)(L + GL_QT + row * GL_ST + cc * 16) = qv[u]; }
        }
        __syncthreads();
        if (MODE == 0) {
            float run = 0.f;
            LAS float* csl = (LAS float*)(L + GL_CS);
#pragma unroll 2
            for (int ii = 0; ii < 16; ++ii) {
                const LAS float* bz = (const LAS float*)(L + GL_BZ) + (16 * qr + ii) * 16;
                float z = bias;
#pragma unroll
                for (int r = 0; r < 16; ++r) z += bz[r] * w2r[r];
                const float ls = -__logf(1.0f + __expf(-fmaxf(z, -80.f)));
                run += ls * (1.0f / 16.0f); csl[(16 * qr + ii) * 128 + dd] = run;
            }
            ((LAS float*)(L + GL_TOT))[qr * 128 + dd] = run;
            __syncthreads();
            float pre = 0.f;
#pragma unroll
            for (int qq = 0; qq < 4; ++qq) { const float tv = ((const LAS float*)(L + GL_TOT))[qq * 128 + dd]; total += tv; if (qq < qr) pre += tv; }
#pragma unroll 2
            for (int ii = 0; ii < 16; ++ii) {
                const int i = 16 * qr + ii; const float Bv = pre + csl[i * 128 + dd];
                Bg[(size_t)i * 1024] = Bv;
                const float kf = bf2f(*(const LAS bf16_t*)(L + GL_KE + i * GL_KST + dd * 2));
                *(LAS bf16_t*)(L + GL_KE + i * GL_KST + dd * 2) = (bf16_t)cvtpk_s(kf * __expf(total - Bv), 0.f);
            }
        } else {
#pragma unroll
            for (int ii = 0; ii < 16; ++ii) {
                const int i = 16 * qr + ii; const float Bv = bpre[ii];
                const float kf = bf2f(*(const LAS bf16_t*)(L + GL_KE + i * GL_KST + dd * 2));
                const float qf = bf2f(*(const LAS bf16_t*)(L + GL_QT + i * GL_ST + dd * 2));
                *(LAS bf16_t*)(L + GL_KE + i * GL_KST + dd * 2) = (bf16_t)cvtpk_s(kf * __expf(total - Bv), 0.f);
                *(LAS bf16_t*)(L + GL_QT + i * GL_ST + dd * 2) = (bf16_t)cvtpk_s(qf * 0.08838834764831845f * __expf(Bv), 0.f);
                *(LAS bf16_t*)(L + GL_KH + i * GL_ST + dd * 2) = (bf16_t)cvtpk_s(kf * __expf(fminf(-Bv, 60.f)), 0.f);
            }
        }
        if (qr == 0) { ((LAS float*)(L + GL_EBL))[dd] = __expf(total); lsum_d += total; }
        __syncthreads();
        bf16x8 vfr[2][2];
#pragma unroll
        for (int kk = 0; kk < 2; ++kk)
#pragma unroll
            for (int nt = 0; nt < 2; ++nt) {
                const LAS unsigned char* vp = L + GL_V + (32 * kk + 8 * g + q4) * GL_VST + (32 * w + 16 * nt + 4 * p4) * 2;
                const v4i16_t lo = vtr(vp), hi = vtr(vp + 4 * GL_VST);
                vfr[kk][nt] = __builtin_shufflevector(lo, hi, 0, 1, 2, 3, 4, 5, 6, 7);
            }
        if (MODE == 1) {
            {
                const int it = w >> 1;
#pragma unroll
                for (int jj = 0; jj < 2; ++jj) {
                    const int jt = 2 * (w & 1) + jj;
                    f32x4 a4 = (f32x4){0.f, 0.f, 0.f, 0.f};
#pragma unroll
                    for (int kk = 0; kk < 4; ++kk) {
                        const bf16x8 a = *(const LAS bf16x8*)(L + GL_QT + (16 * it + c) * GL_ST + (8 * g + 32 * kk) * 2);
                        const bf16x8 b = *(const LAS bf16x8*)(L + GL_KH + (16 * jt + c) * GL_ST + (8 * g + 32 * kk) * 2);
                        a4 = MFMA16(a, b, a4);
                    }
#pragma unroll
                    for (int j = 0; j < 4; ++j) { const int i = 16 * it + 4 * g + j, jc = 16 * jt + c;
                        *(LAS bf16_t*)(L + GL_AM + i * GL_AST + jc * 2) = (bf16_t)f2bf(jc <= i ? a4[j] : 0.f); }
                }
            }
            __syncthreads();
            f32x4 o[2][4];
#pragma unroll
            for (int mt = 0; mt < 2; ++mt)
#pragma unroll
                for (int it = 0; it < 4; ++it) o[mt][it] = (f32x4){0.f, 0.f, 0.f, 0.f};
#pragma unroll
            for (int kq = 0; kq < 4; ++kq) {
                bf16x8 qb[4];
#pragma unroll
                for (int it = 0; it < 4; ++it) {
                    const LAS unsigned char* qp = L + GL_QT + (16 * it + c) * GL_ST + (32 * kq + 4 * g) * 2;
                    const u32x2 lo = *(const LAS u32x2*)qp, hi = *(const LAS u32x2*)(qp + 32);
                    u32x4 t4; t4.x = lo.x; t4.y = lo.y; t4.z = hi.x; t4.w = hi.y; qb[it] = __builtin_bit_cast(bf16x8, t4);
                }
#pragma unroll
                for (int mt = 0; mt < 2; ++mt) {
                    u32x4 sp; const f32x4 s0 = S[2 * kq][mt], s1 = S[2 * kq + 1][mt];
                    sp.x = cvtpk_s(s0[0], s0[1]); sp.y = cvtpk_s(s0[2], s0[3]); sp.z = cvtpk_s(s1[0], s1[1]); sp.w = cvtpk_s(s1[2], s1[3]);
                    const bf16x8 sa = __builtin_bit_cast(bf16x8, sp);
#pragma unroll
                    for (int it = 0; it < 4; ++it) o[mt][it] = MFMA16(sa, qb[it], o[mt][it]);
                }
                __builtin_amdgcn_sched_barrier(0);
            }
#pragma unroll
            for (int kk = 0; kk < 2; ++kk) {
#pragma unroll
                for (int it = 0; it < 4; ++it) {
                    const bf16x8 ab = *(const LAS bf16x8*)(L + GL_AM + (16 * it + c) * GL_AST + (32 * kk + 8 * g) * 2);
#pragma unroll
                    for (int mt = 0; mt < 2; ++mt) o[mt][it] = MFMA16(vfr[kk][mt], ab, o[mt][it]);
                }
                __builtin_amdgcn_sched_barrier(0);
            }
            {
                LAS float* red = (LAS float*)(L + GL_RED);
                u32x2 bwv[2][2];
#pragma unroll
                for (int it = 0; it < 2; ++it)
#pragma unroll
                    for (int mt = 0; mt < 2; ++mt) bwv[it][mt] = *(const u32x2*)(BB + (size_t)(t0 + 16 * it + c) * 3072 + 2048 + hh * 256 + 32 * w + 16 * mt + 4 * g);
                const f32x4 gv0 = *(const f32x4*)(gn + 32 * w + 4 * g), gv1 = *(const f32x4*)(gn + 32 * w + 16 + 4 * g);
#pragma unroll
                for (int it = 0; it < 4; ++it) {
                    float ss = 0.f;
#pragma unroll
                    for (int mt = 0; mt < 2; ++mt) ss += (o[mt][it][0] * o[mt][it][0] + o[mt][it][1] * o[mt][it][1]) + (o[mt][it][2] * o[mt][it][2] + o[mt][it][3] * o[mt][it][3]);
                    ss += __shfl_xor(ss, 16); ss += __shfl_xor(ss, 32);
                    if (g == 0) red[w * 64 + 16 * it + c] = ss;
                }
                __syncthreads();
#pragma unroll
                for (int ih = 0; ih < 2; ++ih) {
                    if (ih == 1) {
#pragma unroll
                        for (int it = 0; it < 2; ++it)
#pragma unroll
                            for (int mt = 0; mt < 2; ++mt) bwv[it][mt] = *(const u32x2*)(BB + (size_t)(t0 + 16 * (2 + it) + c) * 3072 + 2048 + hh * 256 + 32 * w + 16 * mt + 4 * g);
                    }
#pragma unroll
                    for (int i2 = 0; i2 < 2; ++i2) {
                        const int it = 2 * ih + i2;
                        float tot = 0.f;
#pragma unroll
                        for (int ww = 0; ww < 8; ++ww) tot += red[ww * 64 + 16 * it + c];
                        const float rstd = 1.0f / sqrtf(tot * (1.0f / 256.0f) + RMS_EPS);
                        const size_t t = (size_t)(t0 + 16 * it + c);
#pragma unroll
                        for (int mt = 0; mt < 2; ++mt) {
                            const int dv0 = 32 * w + 16 * mt + 4 * g;
                            const f32x4 gv = mt ? gv1 : gv0;
                            const u32x2 bw = bwv[i2][mt];
                            u32x2 ow;
                            ow.x = pk2(o[mt][it][0] * rstd * gv.x * pg8::silu_(bflo(bw.x)), o[mt][it][1] * rstd * gv.y * pg8::silu_(bfhi(bw.x)));
                            ow.y = pk2(o[mt][it][2] * rstd * gv.z * pg8::silu_(bflo(bw.y)), o[mt][it][3] * rstd * gv.w * pg8::silu_(bfhi(bw.y)));
                            *(u32x2*)(Hout + t * 2048 + 1024 + hh * 256 + dv0) = ow;
                        }
                    }
                }
            }
        }
#pragma unroll
        for (int mt = 0; mt < 8; ++mt) {
            const f32x4 sc = *(const LAS f32x4*)(L + GL_EBL + (16 * mt + 4 * g) * 4);
            bf16x8 ka[2];
#pragma unroll
            for (int kk = 0; kk < 2; ++kk) {
                const LAS unsigned char* kp = L + GL_KE + (32 * kk + 8 * g + q4) * GL_KST + (16 * mt + 4 * p4) * 2;
                const v4i16_t lo = vtr(kp), hi = vtr(kp + 4 * GL_KST);
                ka[kk] = __builtin_shufflevector(lo, hi, 0, 1, 2, 3, 4, 5, 6, 7);
            }
#pragma unroll
            for (int nt = 0; nt < 2; ++nt) {
                f32x4 sv = S[mt][nt] * sc;
#pragma unroll
                for (int kk = 0; kk < 2; ++kk) sv = MFMA16(ka[kk], vfr[kk][nt], sv);
                S[mt][nt] = sv;
            }
            __builtin_amdgcn_sched_barrier(0);
        }
    }
    if (MODE == 0) {
#pragma unroll
        for (int mt = 0; mt < 8; ++mt)
#pragma unroll
            for (int nt = 0; nt < 2; ++nt)
                *(f32x4*)(sbase + (unsigned)((((mt * 2 + nt) * 8 + w) * 64 + (16 * g + c)) * 4)) = S[mt][nt];
        if (qr == 0) DG[(hh * 64 + grp) * 128 + dd] = __expf(lsum_d);
    }
    __syncthreads();
}

__constant__ float c_rope_inv[16] = {1.0f, 0.44036660267178046f, 0.19392274474868576f, 0.08539710028576561f, 0.03760603093086393f, 0.016560440080994446f, 0.007292664737217109f, 0.003211445994752591f,
                                     0.001414213562373095f, 0.000622772421914596f, 0.0002742481756762073f, 0.00012076973741146504f, 5.318295896944988e-05f, 2.341999896140934e-05f, 1.031338537721246e-05f, 4.5416704806078695e-06f};

__global__ void __launch_bounds__(NWAVES * 64, 2) fwd_megakernel(Args args) {
    extern __shared__ __attribute__((aligned(16))) unsigned char lds_raw[];
    cg::grid_group grid = cg::this_grid();
    Frame F;
    F.lds = (LAS unsigned char*)lds_raw;
    F.tid = threadIdx.x; F.lane = F.tid & 63; F.wave = __builtin_amdgcn_readfirstlane(F.tid >> 6);
    F.G = gridDim.x; F.gw = blockIdx.x * NWAVES + F.wave; F.NGW = F.G * NWAVES;
    unsigned char* ws = args.ws;
    volatile LAS unsigned* bar_st = (volatile LAS unsigned*)(F.lds + LDS_BYTES - 16);
    if (F.tid < 2) bar_st[F.tid] = 0u;
    __syncthreads();
    const XcdBarrier xbar = xcd_barrier_post((unsigned*)(ws + WS_BAR), bar_st);
    const float* x = args.in[0]; const int* positions = (const int*)args.in[1];
    float* out = args.out;
    bf16_t* Wgu = (bf16_t*)(ws + WS_WGU); bf16_t* Wd = (bf16_t*)(ws + WS_WD); bf16_t* Win = (bf16_t*)(ws + WS_WIN);
    bf16_t* WupA = (bf16_t*)(ws + WS_WUPA);
    bf16_t* Wout = (bf16_t*)(ws + WS_WOUT);
    bf16_t* H = (bf16_t*)(ws + WS_H); bf16_t* ACT = (bf16_t*)(ws + WS_ACT);
    bf16_t* QKVA = (bf16_t*)(ws + WS_QKVA); bf16_t* BB = (bf16_t*)(ws + WS_BB); unsigned char* GATES = (unsigned char*)(ws + WS_GATES);
    bf16_t* X1B = (bf16_t*)args.out;
    bf16_t* X2B = (bf16_t*)(ws + WS_X2B);
    float* BZ = (float*)(ws + WS_BZ);
    bf16_t* Y = (bf16_t*)(ws + WS_Y);

    {
        conv_matrix(F, args.in[3], FF, D, FF, 1, Wgu, 0);
        conv_matrix(F, args.in[4], FF, D, FF, 2, Wgu, 0);
        conv_matrix(F, args.in[5], D, FF, D, 0, Wd, 0);
        conv_matrix(F, args.in[7], 10256, D, NPROJ, 3, Win, 0);
        conv_matrix(F, args.in[13], D, AW, D, 0, WupA, 0, D);
        conv_matrix(F, args.in[14], D, AW, D, 0, WupA + 1024, 1024, D);
        conv_matrix(F, args.in[15], D, D, D, 0, Wout, 0);
        rms_rows_pipelined(F, x, args.in[2], H);
    }
    grid.sync();
    {
        pg8::Gemm g{H, Wgu, M, 2 * FF, D, D, D}; pg8::StaticOrder S; S.init(M, 2 * FF, F.G, (int)blockIdx.x);
        pg8::EpiSwiGLU E{ACT, FF};
        pg8::gemm_phase<pg8::EpiSwiGLU, true>(F.lds, g, S, E);
    }
    xcd_barrier(xbar);
    {
        pg8::Gemm g{ACT, Wd, M, D, FF, FF, FF}; pg8::StaticOrder S; S.init(M, D, F.G, (int)blockIdx.x, 4);
        pg8::EpiResidX<true, false> E{x, X1B, 0.5f};
        pg8::gemm_phase<pg8::EpiResidX<true, false>, true>(F.lds, g, S, E);
    }
    xcd_barrier(xbar);
    {
        LAS float* wz = (LAS float*)F.lds;
        const float* w_in = args.in[7];
        for (int e = F.tid; e < D * 16; e += NWAVES * 64) { const int k = e >> 4, j = e & 15; wz[j * D + k] = w_in[(size_t)k * 10256 + 6144 + j]; }
        __syncthreads();
        f32x4 gv[8], h0[8], h1[8]; load_gain(args.in[6], F.lane, gv);
        for (int m = F.gw; m < M; m += 2 * F.NGW) {
            const int m1 = m + F.NGW; const bool two = m1 < M;
            row_load(X1B + (size_t)m * D, F.lane, h0);
            if (two) row_load(X1B + (size_t)m1 * D, F.lane, h1);
            row_finish(h0, gv, H + (size_t)m * D, F.lane);
            if (two) row_finish(h1, gv, H + (size_t)m1 * D, F.lane);
            float mine0 = 0.f, mine1 = 0.f;
#pragma unroll 1
            for (int j = 0; j < 16; ++j) {
                float a0 = 0.f, a1 = 0.f;
#pragma unroll
                for (int i = 0; i < 8; ++i) { const f32x4 w = *(const LAS f32x4*)(wz + j * D + 256 * i + 4 * F.lane);
                    a0 += (h0[i].x * w.x + h0[i].y * w.y) + (h0[i].z * w.z + h0[i].w * w.w);
                    a1 += (h1[i].x * w.x + h1[i].y * w.y) + (h1[i].z * w.z + h1[i].w * w.w); }
                a0 = wave_sum(a0); a1 = wave_sum(a1);
                if (F.lane == j) { mine0 = a0; mine1 = a1; }
            }
            if (F.lane < 16) { BZ[(size_t)m * 16 + F.lane] = mine0; if (two) BZ[(size_t)m1 * 16 + F.lane] = mine1; }
        }
        __syncthreads();
    }
    xcd_barrier(xbar);
    {
        pg8::Gemm g{H, Win, M, NPROJ, D, D, D}; pg8::StaticOrder S; S.init(M, NPROJ, F.G, (int)blockIdx.x);
        pg8::EpiProj E{QKVA, BB, GATES};
        pg8::gemm_phase<pg8::EpiProj, true>(F.lds, g, S, E);
    }
    xcd_barrier(xbar);
    {
        const float* gq = args.in[8]; const float* gk = args.in[9]; const float* w2 = args.in[10]; const float* gb = args.in[11];
        const int lane = F.lane;
        for (int t = F.gw; t < M; t += F.NGW) {
            const float pos = (float)positions[t];
            unsigned* prow = (unsigned*)(QKVA + (size_t)t * 3072) + lane;
            unsigned wv[16];
#pragma unroll
            for (int v = 0; v < 16; ++v) wv[v] = prow[v * 64];
            float s0 = 0.f, c0 = 1.f, s1 = 0.f, c1 = 1.f;
            if (lane < 16) {
                const int i0 = (2 * lane) & 15;
                const float a0 = pos * c_rope_inv[i0], a1 = pos * c_rope_inv[i0 + 1];
                const double rv0 = (double)a0 * 0.15915494309189535, rv1 = (double)a1 * 0.15915494309189535;
                const float f0 = (float)(rv0 - rint(rv0)), f1 = (float)(rv1 - rint(rv1));
                s0 = __builtin_amdgcn_sinf(f0); c0 = __builtin_amdgcn_cosf(f0); s1 = __builtin_amdgcn_sinf(f1); c1 = __builtin_amdgcn_cosf(f1);
                if (lane < 8) { s0 = -s0; s1 = -s1; }
            }
            const float gq0 = gq[2 * lane], gq1 = gq[2 * lane + 1], gk0 = gk[2 * lane], gk1 = gk[2 * lane + 1];
#pragma unroll
            for (int v = 0; v < 16; ++v) {
                const float x0 = bflo(wv[v]), x1 = bfhi(wv[v]);
                const float ss = wave_sum(x0 * x0 + x1 * x1);
                const float r = 1.0f / sqrtf(ss * (1.0f / 128.0f) + RMS_EPS);
                float y0 = x0 * r * (v < 8 ? gq0 : gk0), y1 = x1 * r * (v < 8 ? gq1 : gk1);
                const float p0 = __shfl_xor(y0, 8), p1 = __shfl_xor(y1, 8);
                if (lane < 16) { y0 = y0 * c0 + p0 * s0; y1 = y1 * c1 + p1 * s1; }
                prow[v * 64] = pk2(y0, y1);
            }
        }
    }
    xcd_barrier(xbar);
    {
        bf16_t* OACC = (bf16_t*)(ws + WS_ORAW); float* LACC = (float*)ws;
        float* SLOC = (float*)(ws + WS_SLOC); float* DG = (float*)(ws + WS_DG);
        const float* gq = args.in[8]; const float* gk = args.in[9];
        const float mq = wave_max(fmaxf(fabsf(gq[2 * F.lane]), fabsf(gq[2 * F.lane + 1]))), mk = wave_max(fmaxf(fabsf(gk[2 * F.lane]), fabsf(gk[2 * F.lane + 1])));
        const float nb2 = -11.313708499f * mq * mk * 1.44269504089f;
        for (int it = blockIdx.x; it < 256; it += F.G) gla_item<0>(F, it >> 6, it & 63, BB, BZ, args.in[10], args.in[11], args.in[12], SLOC, DG, H);
        attn_pass<0>(F, QKVA, OACC, LACC, H, nb2);
        xcd_barrier(xbar);
        for (int e = blockIdx.x * 512 + F.tid; e < 4 * 128 * 256; e += F.G * 512) {
            const int hh = e >> 15, rem = e & 32767, dk = 16 * (rem >> 12) + 4 * ((rem >> 6) & 3) + (rem & 3);
            float run = 0.f;
#pragma unroll 1
            for (int g0 = 0; g0 < 64; g0 += 16) {
                float tv[16], dv_[16];
#pragma unroll
                for (int u = 0; u < 16; ++u) { tv[u] = SLOC[(size_t)(hh * 64 + g0 + u) * 32768 + rem]; dv_[u] = DG[(hh * 64 + g0 + u) * 128 + dk]; }
#pragma unroll
                for (int u = 0; u < 16; ++u) { SLOC[(size_t)(hh * 64 + g0 + u) * 32768 + rem] = run; run = dv_[u] * run + tv[u]; }
            }
        }
        attn_pass<1>(F, QKVA, OACC, LACC, H, nb2);
        xcd_barrier(xbar);
        for (int it = blockIdx.x; it < 256; it += F.G) gla_item<1>(F, it >> 6, it & 63, BB, BZ, args.in[10], args.in[11], args.in[12], SLOC, DG, H);
        attn_pass<2>(F, QKVA, OACC, LACC, H, nb2);
    }
    xcd_barrier(xbar);
    {
        pg8::StaticOrder S; S.init(M, D, F.G, (int)blockIdx.x, 4);
        pg8::Gemm g{H, WupA, M, D, D, D, D}; pg8::EpiGateY E{GATES, Y}; pg8::GateMid HK{GATES};
        pg8::gemm_phase<pg8::EpiGateY, true, pg8::GateMid>(F.lds, g, S, E, HK);
    }
    xcd_barrier(xbar);
    {
        pg8::Gemm g{Y, Wout, M, D, D, D, D}; pg8::StaticOrder S; S.init(M, D, F.G, (int)blockIdx.x, 4);
        pg8::EpiResidX<false, false> E{X1B, X2B, 1.0f};
        pg8::gemm_phase<pg8::EpiResidX<false, false>, true>(F.lds, g, S, E);
    }
    xcd_barrier(xbar);
    {
        conv_matrix(F, args.in[17], FF, D, FF, 1, Wgu, 0);
        conv_matrix(F, args.in[18], FF, D, FF, 2, Wgu, 0);
        conv_matrix(F, args.in[19], D, FF, D, 0, Wd, 0);
        rms_rows_pipelined(F, X2B, args.in[16], H);
    }
    xcd_barrier(xbar);
    {
        pg8::Gemm g{H, Wgu, M, 2 * FF, D, D, D}; pg8::StaticOrder S; S.init(M, 2 * FF, F.G, (int)blockIdx.x);
        pg8::EpiSwiGLU E{ACT, FF};
        pg8::gemm_phase<pg8::EpiSwiGLU, true>(F.lds, g, S, E);
    }
    xcd_barrier(xbar);
    {
        pg8::Gemm g{ACT, Wd, M, D, FF, FF, FF}; pg8::StaticOrder S; S.init(M, D, F.G, (int)blockIdx.x, 4);
        pg8::EpiResidX<false, true> E{X2B, out, 0.5f};
        pg8::gemm_phase<pg8::EpiResidX<false, true>, true>(F.lds, g, S, E);
    }
}

extern "C" void kernel_launch(void* const* d_in, const int* in_sizes, int n_in, void* d_out, int out_size, void* d_ws, size_t ws_size, hipStream_t stream) {
    static int grid = 0;
    if (grid == 0) {
        if (n_in != 20 || in_sizes[0] != M * D || out_size != M * D || ws_size < WS_END) { fprintf(stderr, "kernel_launch: unexpected shapes / workspace (n_in %d, ws %zu)\n", n_in, ws_size); grid = -1; return; }
        int dev = 0, cus = 0, per_cu = 0;
        (void)hipGetDevice(&dev); (void)hipDeviceGetAttribute(&cus, hipDeviceAttributeMultiprocessorCount, dev);
        if (hipFuncSetAttribute((const void*)fwd_megakernel, hipFuncAttributeMaxDynamicSharedMemorySize, LDS_BYTES) != hipSuccess) { fprintf(stderr, "kernel_launch: hipFuncSetAttribute failed\n"); grid = -1; return; }
        if (hipOccupancyMaxActiveBlocksPerMultiprocessor(&per_cu, (const void*)fwd_megakernel, NWAVES * 64, LDS_BYTES) != hipSuccess || per_cu < 1) { fprintf(stderr, "kernel_launch: occupancy query says %d\n", per_cu); (void)hipGetLastError(); }
        grid = cus;
    }
    if (grid < 0) return;
    if (hipMemsetAsync((char*)d_ws + WS_BAR, 0, 16384, stream) != hipSuccess) { fprintf(stderr, "kernel_launch: memset failed\n"); return; }
    Args a{};
    for (int i = 0; i < 20; ++i) a.in[i] = (const float*)d_in[i];
    a.out = (float*)d_out; a.ws = (unsigned char*)d_ws;
    void* kargs[] = {&a};
    hipError_t e = hipLaunchCooperativeKernel((const void*)fwd_megakernel, dim3(grid), dim3(NWAVES * 64), kargs, LDS_BYTES, stream);
    if (e != hipSuccess) fprintf(stderr, "cooperative launch failed: %s (grid %d)\n", hipGetErrorString(e), grid);
}
```

```cpp
#include <hip/hip_runtime.h>
#include <hip/hip_cooperative_groups.h>
#include <cstdio>
#include <cstdint>
namespace cg = cooperative_groups;

#define LAS __attribute__((address_space(3)))
typedef unsigned short bf16_t;
typedef short bf16x8 __attribute__((ext_vector_type(8)));
typedef float f32x4 __attribute__((ext_vector_type(4)));
typedef float f32x2 __attribute__((ext_vector_type(2)));
typedef unsigned u32x4 __attribute__((ext_vector_type(4)));
typedef unsigned u32x2 __attribute__((ext_vector_type(2)));

constexpr int M = 16384, D = 2048, FF = 5632;
constexpr int NPROJ = 10240;
constexpr int AW = 1024;
constexpr float RMS_EPS = 1e-6f;
constexpr int NWAVES = 8;

constexpr size_t MiB = 1u << 20;
constexpr size_t WS_BAR = 768 * 1024;
constexpr size_t WS_BZ = 1 * MiB;
constexpr size_t WS_WGU = 2 * MiB;
constexpr size_t WS_WD = 46 * MiB;
constexpr size_t WS_ORAW = 2 * MiB;
constexpr size_t WS_Y = 2 * MiB;
constexpr size_t WS_WIN = 68 * MiB;
constexpr size_t WS_SLOC = 68 * MiB;
constexpr size_t WS_DG = 100 * MiB;
constexpr size_t WS_WUPA = 108 * MiB, WS_WUPB = 112 * MiB;
constexpr size_t WS_WOUT = 116 * MiB;
constexpr size_t WS_H = 124 * MiB;
constexpr size_t WS_QKVA = 188 * MiB;
constexpr size_t WS_BB = 284 * MiB;
constexpr size_t WS_GATES = 380 * MiB;
constexpr size_t WS_ACT = 188 * MiB;
constexpr size_t WS_T = 188 * MiB;
constexpr size_t WS_X2B = 380 * MiB;
constexpr size_t WS_END = 508 * MiB;

constexpr int LDS_BYTES = 147456;

__device__ __forceinline__ unsigned f2bf(float f) { unsigned u = __builtin_bit_cast(unsigned, f); return (u + 0x7fffu + ((u >> 16) & 1u)) >> 16; }
__device__ __forceinline__ unsigned pk2(float lo, float hi) { return f2bf(lo) | (f2bf(hi) << 16); }
__device__ __forceinline__ float bf2f(unsigned short b) { return __builtin_bit_cast(float, (unsigned)b << 16); }
__device__ __forceinline__ float bflo(unsigned w) { return __builtin_bit_cast(float, w << 16); }
__device__ __forceinline__ float bfhi(unsigned w) { return __builtin_bit_cast(float, w & 0xffff0000u); }
__device__ __forceinline__ float wave_sum(float v) {
#pragma unroll
    for (int o = 1; o < 64; o <<= 1) v += __shfl_xor(v, o);
    return v;
}
__device__ __forceinline__ float wave_max(float v) {
#pragma unroll
    for (int o = 1; o < 64; o <<= 1) v = fmaxf(v, __shfl_xor(v, o));
    return v;
}
__device__ __forceinline__ float sigmoidf_(float x) { return __builtin_amdgcn_rcpf(1.0f + __builtin_amdgcn_exp2f(-1.44269504089f * x)); }

namespace pg8 {
constexpr int BM = 256, BK = 64, HALF = 128, HTB = HALF * BK * 2, STAGE_BYTES = 8 * HTB, NXCD = 8;
__host__ __device__ __forceinline__ int lds_byte(int r, int c) { const int st = (r >> 4) * 2 + (c >> 5), rr = r & 15, cc = c & 31, ob = rr * 64 + cc * 2; return st * 1024 + (ob ^ (((ob >> 9) & 1) << 5)); }
__host__ __device__ __forceinline__ void stage_rc(int b, int& R, int& C) { const int st = b / 1024, sb = b % 1024, swz = sb ^ (((sb >> 9) & 1) << 5); R = (st >> 1) * 16 + swz / 64; C = (st & 1) * 32 + (swz % 64) / 2; }
__host__ __device__ __forceinline__ int perm32(int rho) { const int n = rho >> 4, i = rho & 15; return 8 * (i >> 2) + 4 * n + (i & 3); }

struct Unit { int pm, pn; };
struct Gemm { const bf16_t* A; const bf16_t* Bt; int M, N, K, lda, ldb; };

struct StaticOrder {
    int nM, nN, nwg, G, c, WGM;
    __host__ __device__ void init(int M_, int N_, int G_, int c_, int wgm = 8) { nM = M_ / BM; nN = N_ / BM; nwg = nM * nN; G = G_; c = c_; WGM = wgm; }
    __host__ __device__ bool next(int i, Unit& u) const {
        const long L = (long)i * G + c; if (L >= nwg) return false;
        int wgid = (int)L; { const int q = nwg / NXCD, r = nwg % NXCD, xcd = wgid % NXCD, off = wgid / NXCD; wgid = (xcd < r ? xcd * (q + 1) : r * (q + 1) + (xcd - r) * q) + off; }
        const int nig = WGM * nN, gid = wgid / nig, fm = gid * WGM, gsz = (nM - fm) < WGM ? (nM - fm) : WGM;
        u.pm = fm + ((wgid % nig) % gsz); u.pn = (wgid % nig) / gsz; return true;
    }
};

__device__ __forceinline__ unsigned cvt_pk_bf16(float lo, float hi) { unsigned r; asm volatile("v_cvt_pk_bf16_f32 %0, %1, %2" : "=v"(r) : "v"(lo), "v"(hi)); return r; }

__device__ __forceinline__ float silu_(float g) { return g * __builtin_amdgcn_rcpf(1.0f + __builtin_amdgcn_exp2f(-1.44269504089f * g)); }
__device__ __forceinline__ f32x2 silu_mul_pk(f32x2 g, f32x2 u) {
    const f32x2 t = g * (-1.44269504089f);
    f32x2 e; e.x = __builtin_amdgcn_exp2f(t.x); e.y = __builtin_amdgcn_exp2f(t.y);
    const f32x2 dd = e + 1.0f;
    f32x2 r; r.x = __builtin_amdgcn_rcpf(dd.x); r.y = __builtin_amdgcn_rcpf(dd.y);
    return (g * r) * u;
}
__device__ __forceinline__ f32x2 sigmoid_pk(f32x2 g) {
    const f32x2 t = g * (-1.44269504089f);
    f32x2 e; e.x = __builtin_amdgcn_exp2f(t.x); e.y = __builtin_amdgcn_exp2f(t.y);
    const f32x2 dd = e + 1.0f;
    f32x2 r; r.x = __builtin_amdgcn_rcpf(dd.x); r.y = __builtin_amdgcn_rcpf(dd.y);
    return r;
}

struct EpiSwiGLU {
    static constexpr bool PERM = true;
    bf16_t* O; int ldc;
    __device__ __forceinline__ void operator()(const f32x4 (&acc)[2][2][4][2], const Unit& u, int wr, int wc, int fr, int fq) const {
        const int row0 = u.pm * BM + wr * 64 + fr; const int col0 = u.pn * HALF + wc * 32 + 8 * fq;
#pragma unroll
        for (int ai = 0; ai < 2; ++ai)
#pragma unroll
            for (int m = 0; m < 4; ++m) {
                bf16_t* rowp = O + (size_t)(row0 + ai * HALF + m * 16) * ldc + col0;
                const f32x4 g0 = acc[ai][0][m][0], g1 = acc[ai][0][m][1], u0 = acc[ai][1][m][0], u1 = acc[ai][1][m][1];
                const f32x2 a = silu_mul_pk((f32x2){g0[0], g0[1]}, (f32x2){u0[0], u0[1]}), b = silu_mul_pk((f32x2){g0[2], g0[3]}, (f32x2){u0[2], u0[3]});
                const f32x2 c = silu_mul_pk((f32x2){g1[0], g1[1]}, (f32x2){u1[0], u1[1]}), d = silu_mul_pk((f32x2){g1[2], g1[3]}, (f32x2){u1[2], u1[3]});
                u32x4 w; w.x = cvt_pk_bf16(a.x, a.y); w.y = cvt_pk_bf16(b.x, b.y); w.z = cvt_pk_bf16(c.x, c.y); w.w = cvt_pk_bf16(d.x, d.y);
                *(u32x4*)rowp = w;
            }
    }
};
struct EpiResid {
    static constexpr bool PERM = false;
    const float* base; float* out; int ldc; float scale;
    __device__ __forceinline__ void operator()(const f32x4 (&acc)[2][2][4][2], const Unit& u, int wr, int wc, int fr, int fq) const {
        const int col0 = u.pn * BM + wc * 32 + 4 * fq;
#pragma unroll
        for (int ai = 0; ai < 2; ++ai) {
            f32x4 pre[4][2][2];
#pragma unroll
            for (int m = 0; m < 4; ++m) {
                const size_t off = (size_t)(u.pm * BM + ai * HALF + wr * 64 + m * 16 + fr) * ldc + col0;
#pragma unroll
                for (int bj = 0; bj < 2; ++bj)
#pragma unroll
                    for (int n = 0; n < 2; ++n) pre[m][bj][n] = *(const f32x4*)(base + off + bj * HALF + n * 16);
            }
#pragma unroll
            for (int m = 0; m < 4; ++m) {
                const size_t off = (size_t)(u.pm * BM + ai * HALF + wr * 64 + m * 16 + fr) * ldc + col0;
#pragma unroll
                for (int bj = 0; bj < 2; ++bj)
#pragma unroll
                    for (int n = 0; n < 2; ++n) *(f32x4*)(out + off + bj * HALF + n * 16) = pre[m][bj][n] + acc[ai][bj][m][n] * scale;
            }
        }
    }
};
template <bool IN_F32, bool OUT_F32> struct EpiResidX {
    static constexpr bool PERM = true;
    const void* base; void* out; float scale;
    __device__ __forceinline__ void operator()(const f32x4 (&acc)[2][2][4][2], const Unit& u, int wr, int wc, int fr, int fq) const {
        const int row0 = u.pm * BM + wr * 64 + fr; const int col0 = u.pn * BM + wc * 32 + 8 * fq;
#pragma unroll
        for (int ai = 0; ai < 2; ++ai) {
            f32x4 p0[4][2], p1[4][2];
#pragma unroll
            for (int m = 0; m < 4; ++m)
#pragma unroll
                for (int bj = 0; bj < 2; ++bj) {
                    const size_t e = (size_t)(row0 + ai * HALF + m * 16) * 2048 + col0 + bj * HALF;
                    if (IN_F32) { p0[m][bj] = *(const f32x4*)((const float*)base + e); p1[m][bj] = *(const f32x4*)((const float*)base + e + 4); }
                    else { const u32x4 w = *(const u32x4*)((const bf16_t*)base + e); p0[m][bj] = (f32x4){bflo(w.x), bfhi(w.x), bflo(w.y), bfhi(w.y)}; p1[m][bj] = (f32x4){bflo(w.z), bfhi(w.z), bflo(w.w), bfhi(w.w)}; }
                }
#pragma unroll
            for (int m = 0; m < 4; ++m)
#pragma unroll
                for (int bj = 0; bj < 2; ++bj) {
                    const size_t e = (size_t)(row0 + ai * HALF + m * 16) * 2048 + col0 + bj * HALF;
                    const f32x4 v0 = p0[m][bj] + acc[ai][bj][m][0] * scale, v1 = p1[m][bj] + acc[ai][bj][m][1] * scale;
                    if (OUT_F32) { *(f32x4*)((float*)out + e) = v0; *(f32x4*)((float*)out + e + 4) = v1; }
                    else { u32x4 w; w.x = cvt_pk_bf16(v0[0], v0[1]); w.y = cvt_pk_bf16(v0[2], v0[3]); w.z = cvt_pk_bf16(v1[0], v1[1]); w.w = cvt_pk_bf16(v1[2], v1[3]); *(u32x4*)((bf16_t*)out + e) = w; }
                }
        }
    }
};
__device__ __forceinline__ unsigned qbyte(float sgm) { const float t = fminf(sgm * 256.0f, 255.0f); return (unsigned)t; }
__device__ __forceinline__ float ubyte(unsigned w, int k) { return (float)((w >> (8 * k)) & 0xffu); }
struct EpiProj {
    static constexpr bool PERM = true;
    bf16_t* qkva; bf16_t* bb; unsigned char* gates;
    __device__ __forceinline__ void operator()(const f32x4 (&acc)[2][2][4][2], const Unit& u, int wr, int wc, int fr, int fq) const {
        bf16_t* base = qkva; int ldc = 3072, colt; bool sg = false;
        if (u.pn < 12) { colt = u.pn * BM; } else if (u.pn < 24) { base = bb; colt = (u.pn - 12) * BM; } else { colt = (u.pn - 24) * BM; sg = true; }
        const int row0 = u.pm * BM + wr * 64 + fr; const int col0 = colt + wc * 32 + 8 * fq;
#pragma unroll
        for (int ai = 0; ai < 2; ++ai)
#pragma unroll
            for (int m = 0; m < 4; ++m) {
                bf16_t* rowp = base + (size_t)(row0 + ai * HALF + m * 16) * ldc + col0;
#pragma unroll
                for (int bj = 0; bj < 2; ++bj) {
                    f32x4 v0 = acc[ai][bj][m][0], v1 = acc[ai][bj][m][1];
                    if (sg) {
                        const f32x2 a = sigmoid_pk((f32x2){v0[0], v0[1]}), b = sigmoid_pk((f32x2){v0[2], v0[3]}), c = sigmoid_pk((f32x2){v1[0], v1[1]}), d = sigmoid_pk((f32x2){v1[2], v1[3]});
                        u32x2 qw;
                        qw.x = qbyte(a.x) | (qbyte(a.y) << 8) | (qbyte(b.x) << 16) | (qbyte(b.y) << 24);
                        qw.y = qbyte(c.x) | (qbyte(c.y) << 8) | (qbyte(d.x) << 16) | (qbyte(d.y) << 24);
                        *(u32x2*)(gates + (size_t)(row0 + ai * HALF + m * 16) * 4096 + col0 + bj * HALF) = qw;
                        continue;
                    }
                    u32x4 w; w.x = cvt_pk_bf16(v0[0], v0[1]); w.y = cvt_pk_bf16(v0[2], v0[3]); w.z = cvt_pk_bf16(v1[0], v1[1]); w.w = cvt_pk_bf16(v1[2], v1[3]);
                    *(u32x4*)(rowp + bj * HALF) = w;
                }
            }
    }
};
struct NoHook { static constexpr int AT = -1; __device__ __forceinline__ void operator()(f32x4 (&)[2][2][4][2], const Unit&, int, int, int, int) const {} };
struct GateMid {
    static constexpr int AT = 16;
    const unsigned char* G;
    __device__ __forceinline__ void operator()(f32x4 (&acc)[2][2][4][2], const Unit& u, int wr, int wc, int fr, int fq) const {
        asm volatile("" : "+v"(fr), "+v"(fq));
        const int row0 = u.pm * BM + wr * 64 + fr; const int col0 = u.pn * BM + wc * 32 + 8 * fq;
        const unsigned char* gp = G + (size_t)row0 * 4096 + col0;
#pragma unroll
        for (int ai = 0; ai < 2; ++ai) {
            u32x2 ga[4][2], gb[4][2];
#pragma unroll
            for (int m = 0; m < 4; ++m)
#pragma unroll
                for (int bj = 0; bj < 2; ++bj) { const unsigned r = (unsigned)(ai * HALF + m * 16) * 4096u; ga[m][bj] = *(const u32x2*)(gp + r + bj * HALF); gb[m][bj] = *(const u32x2*)(gp + r + 2048 + bj * HALF); }
            asm volatile("" ::: "memory");
#pragma unroll
            for (int m = 0; m < 4; ++m)
#pragma unroll
                for (int bj = 0; bj < 2; ++bj) {
                    const u32x2 a = ga[m][bj], b = gb[m][bj];
                    f32x4 v0 = acc[ai][bj][m][0], v1 = acc[ai][bj][m][1];
#pragma unroll
                    for (int k = 0; k < 4; ++k) {
                        v0[k] *= (ubyte(a.x, k) + 0.5f) * __builtin_amdgcn_rcpf(ubyte(b.x, k) + 0.5f);
                        v1[k] *= (ubyte(a.y, k) + 0.5f) * __builtin_amdgcn_rcpf(ubyte(b.y, k) + 0.5f);
                    }
                    acc[ai][bj][m][0] = v0; acc[ai][bj][m][1] = v1;
                }
            asm volatile("" ::: "memory");
        }
    }
};
struct EpiGateY {
    static constexpr bool PERM = true;
    const unsigned char* G; bf16_t* Y;
    __device__ __forceinline__ void operator()(const f32x4 (&acc)[2][2][4][2], const Unit& u, int wr, int wc, int fr, int fq) const {
        const int row0 = u.pm * BM + wr * 64 + fr; const int col0 = u.pn * BM + wc * 32 + 8 * fq;
#pragma unroll
        for (int ai = 0; ai < 2; ++ai) {
            u32x2 gpre[4][2];
#pragma unroll
            for (int m = 0; m < 4; ++m)
#pragma unroll
                for (int bj = 0; bj < 2; ++bj) gpre[m][bj] = *(const u32x2*)(G + (size_t)(row0 + ai * HALF + m * 16) * 4096 + 2048 + col0 + bj * HALF);
#pragma unroll
            for (int m = 0; m < 4; ++m) {
                const size_t r = (size_t)(row0 + ai * HALF + m * 16);
#pragma unroll
                for (int bj = 0; bj < 2; ++bj) {
                    const u32x2 g = gpre[m][bj];
                    f32x4 v0 = acc[ai][bj][m][0], v1 = acc[ai][bj][m][1];
#pragma unroll
                    for (int k = 0; k < 4; ++k) { v0[k] *= (ubyte(g.x, k) + 0.5f) * (1.0f / 256.0f); v1[k] *= (ubyte(g.y, k) + 0.5f) * (1.0f / 256.0f); }
                    u32x4 w; w.x = cvt_pk_bf16(v0[0], v0[1]); w.y = cvt_pk_bf16(v0[2], v0[3]); w.z = cvt_pk_bf16(v1[0], v1[1]); w.w = cvt_pk_bf16(v1[2], v1[3]);
                    *(u32x4*)(Y + r * 2048 + col0 + bj * HALF) = w;
                }
            }
        }
    }
};

template <class Epi, bool ALIGN_EPI, class Hook = NoHook>
__device__ __forceinline__ void gemm_phase(LAS unsigned char* lds, const Gemm g, const StaticOrder& S, const Epi& E, const Hook& HK = Hook()) {
    int tid = threadIdx.x; asm volatile("" : "+v"(tid));
    const int wid = __builtin_amdgcn_readfirstlane(tid >> 6), lane = tid & 63, wr = wid >> 2, wc = wid & 3, fr = lane & 15, fq = lane >> 4;
    const int K = g.K, nt = K / BK;
    unsigned voffA[2], voffB[2];
#pragma unroll
    for (int i = 0; i < 2; ++i) { int R, C; stage_rc(tid * 16 + i * 8192, R, C); const int Rb = Epi::PERM ? ((R & ~31) + perm32(R & 31)) : R;
        voffA[i] = (unsigned)(R * g.lda + C) * 2u; voffB[i] = (unsigned)(Rb * g.ldb + C) * 2u; }
    const size_t kstep = (size_t)(BK * 2);
    const size_t hstepA = (size_t)HALF * g.lda * 2, hstepB = (size_t)HALF * g.ldb * 2;
    const size_t tstepA = 2 * hstepA, tstepB = 2 * hstepB;
    const unsigned ldsw = (unsigned)wid * 1024u;
    const int aoff = lds_byte(wr * 64 + fr, fq * 8), boff = lds_byte(wc * 32 + fr, fq * 8);
#define PG8_SA(b, h) (((b) * 2 + (h)) * HTB)
#define PG8_SB(b, h) ((4 + (b) * 2 + (h)) * HTB)
#define PG8_STAGE(bufoff, gbase, voff) do { _Pragma("unroll") for (int _i = 0; _i < 2; ++_i) \
        __builtin_amdgcn_global_load_lds((const unsigned*)((const char*)(gbase) + (voff)[_i]), (LAS unsigned*)(lds + (bufoff) + ldsw + _i * 8192), 16, 0, 0); } while (0)
#define PG8_LDA(dst, b, h) do { _Pragma("unroll") for (int m = 0; m < 4; ++m) _Pragma("unroll") for (int k = 0; k < 2; ++k) dst[m][k] = *(const LAS bf16x8*)(lds + PG8_SA(b, h) + aoff + m * 2048 + k * 1024); } while (0)
#define PG8_LDB(dst, b, h) do { _Pragma("unroll") for (int n = 0; n < 2; ++n) _Pragma("unroll") for (int k = 0; k < 2; ++k) dst[n][k] = *(const LAS bf16x8*)(lds + PG8_SB(b, h) + boff + n * 2048 + k * 1024); } while (0)
#define PG8_MMA(ai, bj, At, Bt) do { __builtin_amdgcn_s_setprio(1); _Pragma("unroll") for (int m = 0; m < 4; ++m) _Pragma("unroll") for (int n = 0; n < 2; ++n) _Pragma("unroll") for (int k = 0; k < 2; ++k) \
        acc[ai][bj][m][n] = __builtin_amdgcn_mfma_f32_16x16x32_bf16(Bt[n][k], At[m][k], acc[ai][bj][m][n], 0, 0, 0); __builtin_amdgcn_s_setprio(0); } while (0)
#define PG8_WAIT_V(n) asm volatile("s_waitcnt vmcnt(" #n ")" ::: "memory")
#define PG8_WAIT_L(n) asm volatile("s_waitcnt lgkmcnt(" #n ")" ::: "memory")
#define PG8_BAR __builtin_amdgcn_s_barrier()
#define PG8_SCHED __builtin_amdgcn_sched_barrier(0)
    Unit cur, nxt; int ui = 0;
    if (!S.next(0, cur)) return;
    f32x4 acc[2][2][4][2];
#pragma unroll
    for (int a = 0; a < 2; ++a)
#pragma unroll
        for (int b = 0; b < 2; ++b)
#pragma unroll
            for (int m = 0; m < 4; ++m)
#pragma unroll
                for (int n = 0; n < 2; ++n) acc[a][b][m][n] = (f32x4){0.f, 0.f, 0.f, 0.f};
    bf16x8 At[4][2], B0[2][2], B1[2][2];
    const char* cA = (const char*)g.A + (size_t)cur.pm * tstepA; const char* cB = (const char*)g.Bt + (size_t)cur.pn * tstepB;
    PG8_STAGE(PG8_SB(0, 0), cB, voffB); PG8_STAGE(PG8_SB(0, 1), cB + hstepB, voffB); PG8_STAGE(PG8_SA(0, 0), cA, voffA); PG8_STAGE(PG8_SA(0, 1), cA + hstepA, voffA);
    if (wr == 1) PG8_BAR;
    PG8_WAIT_V(2); PG8_BAR;
    PG8_STAGE(PG8_SB(1, 0), cB + kstep, voffB); PG8_STAGE(PG8_SA(1, 0), cA + kstep, voffA); PG8_STAGE(PG8_SB(1, 1), cB + hstepB + kstep, voffB);
    PG8_WAIT_V(6); PG8_BAR;
    for (;;) {
        const bool has_next = S.next(ui + 1, nxt);
        const char* nA = has_next ? (const char*)g.A + (size_t)nxt.pm * tstepA : cA; const char* nB = has_next ? (const char*)g.Bt + (size_t)nxt.pn * tstepB : cB;
        for (int t = 0; t < nt; t += 2) {
            if (Hook::AT > 0 && t == Hook::AT) HK(acc, cur, wr, wc, fr, fq);
            const bool last = (t == nt - 2);
            const char* a1 = cA + (size_t)(t + 1) * kstep;
            const char* a2 = last ? nA : cA + (size_t)(t + 2) * kstep; const char* b2 = last ? nB : cB + (size_t)(t + 2) * kstep;
            const char* a3 = a2 + kstep; const char* b3 = b2 + kstep;
            PG8_LDB(B0, 0, 0); PG8_LDB(B1, 0, 1); PG8_SCHED; PG8_LDA(At, 0, 0); PG8_STAGE(PG8_SA(1, 1), a1 + hstepA, voffA);
            PG8_WAIT_V(8); PG8_WAIT_L(0); PG8_BAR; PG8_MMA(0, 0, At, B0); PG8_MMA(0, 1, At, B1); PG8_BAR; PG8_SCHED;
            PG8_LDA(At, 0, 1); PG8_STAGE(PG8_SB(0, 0), b2, voffB); PG8_STAGE(PG8_SB(0, 1), b2 + hstepB, voffB); PG8_STAGE(PG8_SA(0, 0), a2, voffA);
            PG8_WAIT_V(8); PG8_WAIT_L(0); PG8_BAR; PG8_MMA(1, 0, At, B0); PG8_MMA(1, 1, At, B1); PG8_BAR; PG8_SCHED;
            PG8_LDB(B0, 1, 0); PG8_LDB(B1, 1, 1); PG8_SCHED; PG8_LDA(At, 1, 0); PG8_STAGE(PG8_SA(0, 1), a2 + hstepA, voffA);
            PG8_WAIT_V(8); PG8_WAIT_L(0); PG8_BAR; PG8_MMA(0, 0, At, B0); PG8_MMA(0, 1, At, B1); PG8_BAR; PG8_SCHED;
            PG8_LDA(At, 1, 1); PG8_STAGE(PG8_SB(1, 0), b3, voffB); PG8_STAGE(PG8_SB(1, 1), b3 + hstepB, voffB); PG8_STAGE(PG8_SA(1, 0), a3, voffA);
            PG8_WAIT_V(8); PG8_WAIT_L(0); PG8_BAR; PG8_MMA(1, 0, At, B0); PG8_MMA(1, 1, At, B1); PG8_BAR; PG8_SCHED;
        }
        if constexpr (ALIGN_EPI) { if (wr == 0) PG8_BAR; }
        E(acc, cur, wr, wc, fr, fq);
        if (!has_next) break;
#pragma unroll
        for (int a = 0; a < 2; ++a)
#pragma unroll
            for (int b = 0; b < 2; ++b)
#pragma unroll
                for (int m = 0; m < 4; ++m)
#pragma unroll
                    for (int n = 0; n < 2; ++n) acc[a][b][m][n] = (f32x4){0.f, 0.f, 0.f, 0.f};
        cur = nxt; cA = nA; cB = nB; ++ui;
        if constexpr (ALIGN_EPI) { if (wr == 1) PG8_BAR; }
    }
    PG8_WAIT_V(0);
    if constexpr (!ALIGN_EPI) { if (wr == 0) PG8_BAR; }
    PG8_BAR;
#undef PG8_SA
#undef PG8_SB
#undef PG8_STAGE
#undef PG8_LDA
#undef PG8_LDB
#undef PG8_MMA
#undef PG8_WAIT_V
#undef PG8_WAIT_L
#undef PG8_BAR
#undef PG8_SCHED
}
}


#define XB_TMO      128
#define XB_XCNT(j)  (256  + 64 * (j))
#define XB_XSUB(j)  (1280 + 64 * (j))
#define XB_XGEN(j)  (2304 + 64 * (j))
#define XB_TOP      3328
#define XB_TOPGEN   3392
#define XCD_BAR_WORDS 3456
#define XB_SPIN_CAP (1u << 20)
__device__ __forceinline__ unsigned xb_ld(unsigned* p)              { return __hip_atomic_load(p, __ATOMIC_RELAXED, __HIP_MEMORY_SCOPE_AGENT); }
__device__ __forceinline__ unsigned xb_add(unsigned* p, unsigned v) { return __hip_atomic_fetch_add(p, v, __ATOMIC_RELAXED, __HIP_MEMORY_SCOPE_AGENT); }
__device__ __forceinline__ unsigned xb_xcc_id() { return (unsigned)__builtin_amdgcn_s_getreg((3 << 11) | 20) & 0xFu; }
#define XB_SPIN(cond, bar) do { unsigned _sp = 0; while (cond) { __builtin_amdgcn_s_sleep(1); \
    if ((++_sp & 255u) == 0u) { if (xb_ld(&(bar)[XB_TMO])) break; if (_sp > XB_SPIN_CAP) { atomicAdd(&(bar)[XB_TMO], 1u); break; } } } } while (0)
struct XcdBarrier { unsigned* bar; unsigned x; volatile LAS unsigned* st; };
__device__ __forceinline__ XcdBarrier xcd_barrier_post(unsigned* bar, volatile LAS unsigned* st) {
    XcdBarrier b; b.bar = bar; b.x = xb_xcc_id(); b.st = st;
    if (threadIdx.x == 0) (void)xb_add(&bar[XB_XCNT(b.x)], 1u);
    return b;
}
__device__ __forceinline__ void xcd_barrier_complete(unsigned* bar, unsigned x, unsigned& nloc, unsigned& nx) {
    const unsigned G = gridDim.x * gridDim.y * gridDim.z;
    unsigned sum, cnt, mine, sp = 0u;
    for (;;) {
        sum = 0u; cnt = 0u; mine = 0u;
#pragma unroll
        for (unsigned j = 0; j < 16; ++j) { const unsigned c = xb_ld(&bar[XB_XCNT(j)]); sum += c; cnt += (c > 0u) ? 1u : 0u; mine = (j == x) ? c : mine; }
        if (sum == G) break;
        __builtin_amdgcn_s_sleep(1);
        if ((++sp & 255u) == 0u) { if (xb_ld(&bar[XB_TMO])) break; if (sp > XB_SPIN_CAP) { atomicAdd(&bar[XB_TMO], 1u); break; } }
    }
    nloc = mine > 0u ? mine : 1u; nx = cnt > 0u ? cnt : 1u;
}
__device__ __forceinline__ void xcd_barrier(const XcdBarrier& b) {
    asm volatile("s_waitcnt vmcnt(0)" ::: "memory");
    __syncthreads();
    if (threadIdx.x == 0) {
        unsigned* bar = b.bar;
        __builtin_amdgcn_s_waitcnt(0);
        unsigned nloc = b.st[0], nx = b.st[1];
        if (nloc == 0u) { xcd_barrier_complete(bar, b.x, nloc, nx); b.st[0] = nloc; b.st[1] = nx; }
        const unsigned old = xb_add(&bar[XB_XSUB(b.x)], 1u);
        const unsigned gen = old / nloc;
        if (old + 1u == (gen + 1u) * nloc) {
            __builtin_amdgcn_fence(__ATOMIC_RELEASE, "agent");
            asm volatile("s_waitcnt vmcnt(0)" ::: "memory");
            const unsigned og = xb_add(&bar[XB_TOP], 1u);
            const unsigned tg = og / nx;
            if (og + 1u == (tg + 1u) * nx) xb_add(&bar[XB_TOPGEN], 1u);
            else XB_SPIN(xb_ld(&bar[XB_TOPGEN]) == tg, bar);
            __builtin_amdgcn_fence(__ATOMIC_ACQUIRE, "agent");
            xb_add(&bar[XB_XGEN(b.x)], 1u);
            asm volatile("s_waitcnt vmcnt(0)" ::: "memory");
        } else {
            XB_SPIN(xb_ld(&bar[XB_XGEN(b.x)]) == gen, bar);
            __builtin_amdgcn_fence(__ATOMIC_ACQUIRE, "agent");
            asm volatile("s_waitcnt vmcnt(0)" ::: "memory");
        }
    }
    __syncthreads();
}

struct Args { const float* in[20]; float* out; unsigned char* ws; };

struct Frame {
    LAS unsigned char* lds;
    int tid, lane, wave, G, gw, NGW;
};

__device__ __forceinline__ void transpose_item(const float* W, int ldw, int ldt, bf16_t* WT, int src_col0, int dst_row0, int k0, LAS float* scr, int lane) {
    float v[32];
    const float* wp = W + (size_t)(k0 + (lane >> 5)) * ldw + src_col0 + (lane & 31);
#pragma unroll
    for (int i = 0; i < 32; ++i) v[i] = wp[(size_t)(2 * i) * ldw];
#pragma unroll
    for (int i = 0; i < 32; ++i) { const int kk = 2 * i + (lane >> 5); scr[kk * 33 + (lane & 31)] = v[i]; }
    asm volatile("s_waitcnt lgkmcnt(0)" ::: "memory");
    const int c = lane & 7;
#pragma unroll
    for (int j = 0; j < 4; ++j) { const int n = (lane >> 3) + 8 * j; const LAS float* s = scr + (8 * c) * 33 + n;
        u32x4 o; o.x = pk2(s[0 * 33], s[1 * 33]); o.y = pk2(s[2 * 33], s[3 * 33]); o.z = pk2(s[4 * 33], s[5 * 33]); o.w = pk2(s[6 * 33], s[7 * 33]);
        *(u32x4*)(WT + (size_t)(dst_row0 + n) * ldt + k0 + 8 * c) = o; }
    asm volatile("s_waitcnt lgkmcnt(0)" ::: "memory");
}
__device__ __forceinline__ void conv_matrix(const Frame& F, const float* W, int ldw, int K, int ncols_dst, int mode, bf16_t* WT, int rot, int ldt = 0) {
    if (ldt == 0) ldt = K;
    LAS float* scr = (LAS float*)(F.lds + F.wave * 16384);
    const int nblk = ncols_dst / 32, nitems = (K / 64) * nblk;
    int start = F.gw - rot; if (start < 0) start += F.NGW;
    for (int it = start; it < nitems; it += F.NGW) {
        const int kb = it / nblk, nb = it % nblk;
        int src = 32 * nb, dst = 32 * nb;
        if (mode == 1) dst = 256 * (nb >> 2) + 32 * (nb & 3);
        else if (mode == 2) dst = 256 * (nb >> 2) + 128 + 32 * (nb & 3);
        else if (mode == 3) src = 32 * nb + (32 * nb >= 6144 ? 16 : 0);
        transpose_item(W, ldw, ldt, WT, src, dst, 64 * kb, scr, F.lane);
    }
}

__device__ __forceinline__ void load_gain(const float* gain, int lane, f32x4 (&gv)[8]) {
#pragma unroll
    for (int j = 0; j < 8; ++j) gv[j] = ((const f32x4*)gain + lane)[64 * j];
}
__device__ __forceinline__ void rms_row(const float* xrow, const f32x4 (&gv)[8], bf16_t* orow, int lane, f32x4 (&hv)[8]) {
    const f32x4* xr = (const f32x4*)xrow + lane;
    float s = 0.f;
#pragma unroll
    for (int j = 0; j < 8; ++j) { hv[j] = xr[64 * j]; s += (hv[j].x * hv[j].x + hv[j].y * hv[j].y) + (hv[j].z * hv[j].z + hv[j].w * hv[j].w); }
    const float r = 1.0f / sqrtf(wave_sum(s) * (1.0f / D) + RMS_EPS);
    u32x2* o8 = (u32x2*)orow + lane;
#pragma unroll
    for (int j = 0; j < 8; ++j) { hv[j] = hv[j] * r * gv[j]; u32x2 w; w.x = pk2(hv[j].x, hv[j].y); w.y = pk2(hv[j].z, hv[j].w); o8[64 * j] = w; }
}

__device__ __forceinline__ void row_load(const bf16_t* xrow, int lane, f32x4 (&xv)[8]) {
    const u32x2* xr = (const u32x2*)xrow + lane;
#pragma unroll
    for (int j = 0; j < 8; ++j) { const u32x2 w = xr[64 * j]; xv[j] = (f32x4){bflo(w.x), bfhi(w.x), bflo(w.y), bfhi(w.y)}; }
}
__device__ __forceinline__ void row_load(const float* xrow, int lane, f32x4 (&xv)[8]) {
    const f32x4* xr = (const f32x4*)xrow + lane;
#pragma unroll
    for (int j = 0; j < 8; ++j) xv[j] = xr[64 * j];
}
__device__ __forceinline__ void row_finish(f32x4 (&xv)[8], const f32x4 (&gv)[8], bf16_t* orow, int lane) {
    float s = 0.f;
#pragma unroll
    for (int j = 0; j < 8; ++j) s += (xv[j].x * xv[j].x + xv[j].y * xv[j].y) + (xv[j].z * xv[j].z + xv[j].w * xv[j].w);
    const float r = 1.0f / sqrtf(wave_sum(s) * (1.0f / D) + RMS_EPS);
    u32x2* o8 = (u32x2*)orow + lane;
#pragma unroll
    for (int j = 0; j < 8; ++j) { xv[j] = xv[j] * r * gv[j]; u32x2 w; w.x = pk2(xv[j].x, xv[j].y); w.y = pk2(xv[j].z, xv[j].w); o8[64 * j] = w; }
}
template <class XT>
__device__ __forceinline__ void rms_rows_pipelined(const Frame& F, const XT* X, const float* gain, bf16_t* Hout) {
    f32x4 gv[8], xa[8], xb[8]; load_gain(gain, F.lane, gv);
    int m = F.gw;
    if (m < M) row_load(X + (size_t)m * D, F.lane, xa);
    for (; m < M; m += F.NGW) {
        const int mn = m + F.NGW;
        if (mn < M) row_load(X + (size_t)mn * D, F.lane, xb);
        row_finish(xa, gv, Hout + (size_t)m * D, F.lane);
#pragma unroll
        for (int j = 0; j < 8; ++j) xa[j] = xb[j];
    }
}

typedef short v4i16_t __attribute__((ext_vector_type(4)));
typedef float f32x2_t __attribute__((ext_vector_type(2))); typedef __bf16 bf16x2_t __attribute__((ext_vector_type(2)));
__device__ __forceinline__ unsigned cvtpk_s(float lo, float hi) { f32x2_t v = {lo, hi}; bf16x2_t b = __builtin_convertvector(v, bf16x2_t); return __builtin_bit_cast(unsigned, b); }
__device__ __forceinline__ v4i16_t vtr(const LAS unsigned char* p) { return __builtin_amdgcn_ds_read_tr16_b64_v4i16((LAS v4i16_t*)p); }
#define MFMA16(a, b, c) __builtin_amdgcn_mfma_f32_16x16x32_bf16((a), (b), (c), 0, 0, 0)

template <int PASS>
__device__ __forceinline__ void attn_pass(const Frame& F, const bf16_t* QKVA, bf16_t* OACC, float* LACC, bf16_t* Hout, float nb2) {
    constexpr int d = 1 << (2 * PASS);
    constexpr int KST = 272, VST = 288;
    LAS unsigned char* Kl = F.lds; LAS unsigned char* Vl = F.lds + 256 * KST;
    int lane = F.lane; asm volatile("" : "+v"(lane));
    const int w = F.wave, g = lane >> 4, c = lane & 15, q4 = c >> 2, p4 = c & 3;
    constexpr float SCL = 0.08838834764831845f * 1.44269504089f;
    u32x4 kpre[8], vpre[8]; bf16x8 qpre[4];
    auto issue = [&](int idx) {
        const int h = idx & 7, blk = idx >> 3, r = blk % d, n = blk / d;
        { const size_t tqn = (size_t)(n * 128 + 16 * w + c) * d + r;
#pragma unroll
          for (int kk = 0; kk < 4; ++kk) qpre[kk] = *(const bf16x8*)(QKVA + tqn * 3072 + h * 128 + 8 * g + 32 * kk); }
#pragma unroll
        for (int u = 0; u < 8; ++u) {
            const int e = F.tid + 512 * u, row = e >> 4, ch = e & 15;
            int mrow = (n - 1) * 128 + row; if (mrow < 0) mrow = 0;
            const size_t t = (size_t)mrow * d + r;
            kpre[u] = *(const u32x4*)(QKVA + t * 3072 + 1024 + h * 128 + ch * 8);
            vpre[u] = *(const u32x4*)(QKVA + t * 3072 + 2048 + h * 128 + ch * 8);
        }
    };
    if ((int)blockIdx.x < 1024) issue(blockIdx.x);
    for (int idx = blockIdx.x; idx < 1024; idx += F.G) {
        const int h = idx & 7, blk = idx >> 3, r = blk % d, n = blk / d;
        __syncthreads();
#pragma unroll
        for (int u = 0; u < 8; ++u) {
            const int e = F.tid + 512 * u, row = e >> 4, ch = e & 15;
            *(LAS u32x4*)(Kl + row * KST + ch * 16) = kpre[u];
            *(LAS u32x4*)(Vl + row * VST + ch * 16) = vpre[u];
        }
        __syncthreads();
        bf16x8 qf[4];
#pragma unroll
        for (int kk = 0; kk < 4; ++kk) qf[kk] = qpre[kk];
        if (idx + F.G < 1024) issue(idx + F.G);
        const int qi = 16 * w + c;
        const size_t tq = (size_t)(n * 128 + qi) * d + r;
        f32x4 accO[8];
        bf16_t* op = OACC + tq * 1024 + h * 128 + 4 * g;
        float lsum = 0.f;
        if (PASS > 0) {
#pragma unroll
            for (int nt = 0; nt < 8; ++nt) { const u32x2 pv = *(const u32x2*)(op + 16 * nt); accO[nt] = (f32x4){bflo(pv.x), bfhi(pv.x), bflo(pv.y), bfhi(pv.y)}; }
            lsum = (g == 0) ? LACC[tq * 8 + h] : 0.f;
        } else {
#pragma unroll
            for (int nt = 0; nt < 8; ++nt) accO[nt] = (f32x4){0.f, 0.f, 0.f, 0.f};
        }
#pragma unroll 1
        for (int ks = 0; ks < 5; ++ks) {
            u32x4 pw;
#pragma unroll
            for (int half = 0; half < 2; ++half) {
                const int kt = w + 2 * ks + half; const int ktc = kt < 16 ? kt : 15;
                f32x4 sv = (f32x4){0.f, 0.f, 0.f, 0.f};
#pragma unroll
                for (int kk = 0; kk < 4; ++kk) { const bf16x8 a = *(const LAS bf16x8*)(Kl + (16 * ktc + c) * KST + (8 * g + 32 * kk) * 2); sv = MFMA16(a, qf[kk], sv); }
                float pj[4];
#pragma unroll
                for (int j = 0; j < 4; ++j) { const int kj = 16 * kt + 4 * g + j; const bool valid = (kj >= qi) && (kj <= qi + 128) && (n > 0 || kj >= 128);
                    pj[j] = valid ? __builtin_amdgcn_exp2f(sv[j] * SCL + nb2) : 0.f; lsum += pj[j]; }
                if (half == 0) { pw.x = cvtpk_s(pj[0], pj[1]); pw.y = cvtpk_s(pj[2], pj[3]); } else { pw.z = cvtpk_s(pj[0], pj[1]); pw.w = cvtpk_s(pj[2], pj[3]); }
            }
            const bf16x8 pa = __builtin_bit_cast(bf16x8, pw);
            const int kt0 = w + 2 * ks, kt1 = (kt0 + 1 < 16) ? kt0 + 1 : 15;
            const LAS unsigned char* v0 = Vl + (16 * kt0 + 4 * g + q4) * VST + 8 * p4;
            const LAS unsigned char* v1 = Vl + (16 * kt1 + 4 * g + q4) * VST + 8 * p4;
#pragma unroll
            for (int nt = 0; nt < 8; ++nt) {
                const v4i16_t lo = vtr(v0 + 32 * nt), hi = vtr(v1 + 32 * nt);
                const bf16x8 vf = __builtin_shufflevector(lo, hi, 0, 1, 2, 3, 4, 5, 6, 7);
                accO[nt] = MFMA16(vf, pa, accO[nt]);
            }
        }
        lsum += __shfl_xor(lsum, 16); lsum += __shfl_xor(lsum, 32);
        if (PASS < 2) {
#pragma unroll
            for (int nt = 0; nt < 8; ++nt) { u32x2 o; o.x = cvtpk_s(accO[nt][0], accO[nt][1]); o.y = cvtpk_s(accO[nt][2], accO[nt][3]); *(u32x2*)(op + 16 * nt) = o; }
            if (g == 0) LACC[tq * 8 + h] = lsum;
        } else {
            const float il = 1.0f / lsum;
            bf16_t* hp = Hout + tq * 2048 + h * 128 + 4 * g;
#pragma unroll
            for (int nt = 0; nt < 8; ++nt) { u32x2 o; o.x = cvtpk_s(accO[nt][0] * il, accO[nt][1] * il); o.y = cvtpk_s(accO[nt][2] * il, accO[nt][3] * il); *(u32x2*)(hp + 16 * nt) = o; }
        }
    }
    __syncthreads();
}

constexpr int GL_QT = 0, GL_KH = 17408, GL_KE = 34816, GL_V = 53248, GL_AM = 88064, GL_BZ = 97280, GL_TOT = 101376, GL_EBL = 103424, GL_RED = 103936, GL_CS = 105984;
constexpr int GL_ST = 272, GL_KST = 288, GL_VST = 544, GL_AST = 144;
template <int MODE>
__device__ __forceinline__ void gla_item(const Frame& F, int hh, int grp, const bf16_t* BB, const float* BZ, const float* w2g, const float* biasg, const float* gn, bf16_t* SLOC, float* DG, bf16_t* Hout) {
    LAS unsigned char* L = F.lds;
    const int tid = F.tid, lane = F.lane, w = F.wave; int g = lane >> 4, c = lane & 15; asm volatile("" : "+v"(g), "+v"(c));
    const int q4 = c >> 2, p4 = c & 3;
    const int dd = tid & 127, qr = tid >> 7;
    f32x4 S[8][2];
    bf16_t* sbase = SLOC + ((size_t)(hh * 64 + grp) * 128) * 256;
#pragma unroll
    for (int mt = 0; mt < 8; ++mt)
#pragma unroll
        for (int nt = 0; nt < 2; ++nt) {
            if (MODE == 0) S[mt][nt] = (f32x4){0.f, 0.f, 0.f, 0.f};
            else {
                { const u32x2 pw = *(const u32x2*)(sbase + (unsigned)((((mt * 2 + nt) * 8 + w) * 64 + (16 * g + c)) * 4)); S[mt][nt] = (f32x4){bflo(pw.x), bfhi(pw.x), bflo(pw.y), bfhi(pw.y)}; }
            }
        }
    float w2r[16];
#pragma unroll
    for (int r = 0; r < 16; ++r) w2r[r] = w2g[r * 512 + hh * 128 + dd];
    const float bias = biasg[hh * 128 + dd];
    float lsum_d = 0.f;
#pragma unroll 1
    for (int ch = 0; ch < 4; ++ch) {
        const int t0 = (grp * 4 + ch) * 64;
        __syncthreads();
        float* Bg = (float*)Hout + (size_t)t0 * 1024 + 512 + hh * 128 + dd;
        float bpre[16]; float total = 0.f;
        if (MODE == 0) { if (tid < 256) *(LAS f32x4*)(L + GL_BZ + tid * 16) = *(const f32x4*)(BZ + (size_t)t0 * 16 + tid * 4); }
        else {
#pragma unroll
            for (int ii = 0; ii < 16; ++ii) bpre[ii] = Bg[(size_t)(16 * qr + ii) * 1024];
            total = Bg[(size_t)63 * 1024];
        }
        {
            u32x4 vv[4], kv[2], qv[2];
#pragma unroll
            for (int u = 0; u < 4; ++u) { const int e = tid + 512 * u, row = e >> 5, cc = e & 31; vv[u] = *(const u32x4*)(BB + (size_t)(t0 + row) * 3072 + 1024 + hh * 256 + cc * 8); }
#pragma unroll
            for (int u = 0; u < 2; ++u) { const int e = tid + 512 * u, row = e >> 4, cc = e & 15; kv[u] = *(const u32x4*)(BB + (size_t)(t0 + row) * 3072 + 512 + hh * 128 + cc * 8);
                if (MODE == 1) qv[u] = *(const u32x4*)(BB + (size_t)(t0 + row) * 3072 + hh * 128 + cc * 8); }
#pragma unroll
            for (int u = 0; u < 4; ++u) { const int e = tid + 512 * u, row = e >> 5, cc = e & 31; *(LAS u32x4*)(L + GL_V + row * GL_VST + cc * 16) = vv[u]; }
#pragma unroll
            for (int u = 0; u < 2; ++u) { const int e = tid + 512 * u, row = e >> 4, cc = e & 15; *(LAS u32x4*)(L + GL_KE + row * GL_KST + cc * 16) = kv[u];
                if (MODE == 1) *(LAS u32x4*)(L + GL_QT + row * GL_ST + cc * 16) = qv[u]; }
        }
        __syncthreads();
        if (MODE == 0) {
            float run = 0.f;
            LAS float* csl = (LAS float*)(L + GL_CS);
#pragma unroll 2
            for (int ii = 0; ii < 16; ++ii) {
                const LAS float* bz = (const LAS float*)(L + GL_BZ) + (16 * qr + ii) * 16;
                float z = bias;
#pragma unroll
                for (int r = 0; r < 16; ++r) z += bz[r] * w2r[r];
                const float ls = -__logf(1.0f + __expf(-fmaxf(z, -80.f)));
                run += ls * (1.0f / 16.0f); csl[(16 * qr + ii) * 128 + dd] = run;
            }
            ((LAS float*)(L + GL_TOT))[qr * 128 + dd] = run;
            __syncthreads();
            float pre = 0.f;
#pragma unroll
            for (int qq = 0; qq < 4; ++qq) { const float tv = ((const LAS float*)(L + GL_TOT))[qq * 128 + dd]; total += tv; if (qq < qr) pre += tv; }
#pragma unroll 2
            for (int ii = 0; ii < 16; ++ii) {
                const int i = 16 * qr + ii; const float Bv = pre + csl[i * 128 + dd];
                Bg[(size_t)i * 1024] = Bv;
                const float kf = bf2f(*(const LAS bf16_t*)(L + GL_KE + i * GL_KST + dd * 2));
                *(LAS bf16_t*)(L + GL_KE + i * GL_KST + dd * 2) = (bf16_t)cvtpk_s(kf * __expf(total - Bv), 0.f);
            }
        } else {
#pragma unroll
            for (int ii = 0; ii < 16; ++ii) {
                const int i = 16 * qr + ii; const float Bv = bpre[ii];
                const float kf = bf2f(*(const LAS bf16_t*)(L + GL_KE + i * GL_KST + dd * 2));
                const float qf = bf2f(*(const LAS bf16_t*)(L + GL_QT + i * GL_ST + dd * 2));
                *(LAS bf16_t*)(L + GL_KE + i * GL_KST + dd * 2) = (bf16_t)cvtpk_s(kf * __expf(total - Bv), 0.f);
                *(LAS bf16_t*)(L + GL_QT + i * GL_ST + dd * 2) = (bf16_t)cvtpk_s(qf * 0.08838834764831845f * __expf(Bv), 0.f);
                *(LAS bf16_t*)(L + GL_KH + i * GL_ST + dd * 2) = (bf16_t)cvtpk_s(kf * __expf(fminf(-Bv, 60.f)), 0.f);
            }
        }
        if (qr == 0) { ((LAS float*)(L + GL_EBL))[dd] = __expf(total); lsum_d += total; }
        __syncthreads();
        bf16x8 vfr[2][2];
#pragma unroll
        for (int kk = 0; kk < 2; ++kk)
#pragma unroll
            for (int nt = 0; nt < 2; ++nt) {
                const LAS unsigned char* vp = L + GL_V + (32 * kk + 8 * g + q4) * GL_VST + (32 * w + 16 * nt + 4 * p4) * 2;
                const v4i16_t lo = vtr(vp), hi = vtr(vp + 4 * GL_VST);
                vfr[kk][nt] = __builtin_shufflevector(lo, hi, 0, 1, 2, 3, 4, 5, 6, 7);
            }
        if (MODE == 1) {
            {
                const int it = w >> 1;
#pragma unroll
                for (int jj = 0; jj < 2; ++jj) {
                    const int jt = 2 * (w & 1) + jj;
                    f32x4 a4 = (f32x4){0.f, 0.f, 0.f, 0.f};
#pragma unroll
                    for (int kk = 0; kk < 4; ++kk) {
                        const bf16x8 a = *(const LAS bf16x8*)(L + GL_QT + (16 * it + c) * GL_ST + (8 * g + 32 * kk) * 2);
                        const bf16x8 b = *(const LAS bf16x8*)(L + GL_KH + (16 * jt + c) * GL_ST + (8 * g + 32 * kk) * 2);
                        a4 = MFMA16(a, b, a4);
                    }
#pragma unroll
                    for (int j = 0; j < 4; ++j) { const int i = 16 * it + 4 * g + j, jc = 16 * jt + c;
                        *(LAS bf16_t*)(L + GL_AM + i * GL_AST + jc * 2) = (bf16_t)f2bf(jc <= i ? a4[j] : 0.f); }
                }
            }
            __syncthreads();
            f32x4 o[2][4];
#pragma unroll
            for (int mt = 0; mt < 2; ++mt)
#pragma unroll
                for (int it = 0; it < 4; ++it) o[mt][it] = (f32x4){0.f, 0.f, 0.f, 0.f};
#pragma unroll
            for (int kq = 0; kq < 4; ++kq) {
                bf16x8 qb[4];
#pragma unroll
                for (int it = 0; it < 4; ++it) {
                    const LAS unsigned char* qp = L + GL_QT + (16 * it + c) * GL_ST + (32 * kq + 4 * g) * 2;
                    const u32x2 lo = *(const LAS u32x2*)qp, hi = *(const LAS u32x2*)(qp + 32);
                    u32x4 t4; t4.x = lo.x; t4.y = lo.y; t4.z = hi.x; t4.w = hi.y; qb[it] = __builtin_bit_cast(bf16x8, t4);
                }
#pragma unroll
                for (int mt = 0; mt < 2; ++mt) {
                    u32x4 sp; const f32x4 s0 = S[2 * kq][mt], s1 = S[2 * kq + 1][mt];
                    sp.x = cvtpk_s(s0[0], s0[1]); sp.y = cvtpk_s(s0[2], s0[3]); sp.z = cvtpk_s(s1[0], s1[1]); sp.w = cvtpk_s(s1[2], s1[3]);
                    const bf16x8 sa = __builtin_bit_cast(bf16x8, sp);
#pragma unroll
                    for (int it = 0; it < 4; ++it) o[mt][it] = MFMA16(sa, qb[it], o[mt][it]);
                }
                __builtin_amdgcn_sched_barrier(0);
            }
#pragma unroll
            for (int kk = 0; kk < 2; ++kk) {
#pragma unroll
                for (int it = 0; it < 4; ++it) {
                    const bf16x8 ab = *(const LAS bf16x8*)(L + GL_AM + (16 * it + c) * GL_AST + (32 * kk + 8 * g) * 2);
#pragma unroll
                    for (int mt = 0; mt < 2; ++mt) o[mt][it] = MFMA16(vfr[kk][mt], ab, o[mt][it]);
                }
                __builtin_amdgcn_sched_barrier(0);
            }
            {
                LAS float* red = (LAS float*)(L + GL_RED);
                u32x2 bwv[2][2];
#pragma unroll
                for (int it = 0; it < 2; ++it)
#pragma unroll
                    for (int mt = 0; mt < 2; ++mt) bwv[it][mt] = *(const u32x2*)(BB + (size_t)(t0 + 16 * it + c) * 3072 + 2048 + hh * 256 + 32 * w + 16 * mt + 4 * g);
                const f32x4 gv0 = *(const f32x4*)(gn + 32 * w + 4 * g), gv1 = *(const f32x4*)(gn + 32 * w + 16 + 4 * g);
#pragma unroll
                for (int it = 0; it < 4; ++it) {
                    float ss = 0.f;
#pragma unroll
                    for (int mt = 0; mt < 2; ++mt) ss += (o[mt][it][0] * o[mt][it][0] + o[mt][it][1] * o[mt][it][1]) + (o[mt][it][2] * o[mt][it][2] + o[mt][it][3] * o[mt][it][3]);
                    ss += __shfl_xor(ss, 16); ss += __shfl_xor(ss, 32);
                    if (g == 0) red[w * 64 + 16 * it + c] = ss;
                }
                __syncthreads();
#pragma unroll
                for (int ih = 0; ih < 2; ++ih) {
                    if (ih == 1) {
#pragma unroll
                        for (int it = 0; it < 2; ++it)
#pragma unroll
                            for (int mt = 0; mt < 2; ++mt) bwv[it][mt] = *(const u32x2*)(BB + (size_t)(t0 + 16 * (2 + it) + c) * 3072 + 2048 + hh * 256 + 32 * w + 16 * mt + 4 * g);
                    }
#pragma unroll
                    for (int i2 = 0; i2 < 2; ++i2) {
                        const int it = 2 * ih + i2;
                        float tot = 0.f;
#pragma unroll
                        for (int ww = 0; ww < 8; ++ww) tot += red[ww * 64 + 16 * it + c];
                        const float rstd = 1.0f / sqrtf(tot * (1.0f / 256.0f) + RMS_EPS);
                        const size_t t = (size_t)(t0 + 16 * it + c);
#pragma unroll
                        for (int mt = 0; mt < 2; ++mt) {
                            const int dv0 = 32 * w + 16 * mt + 4 * g;
                            const f32x4 gv = mt ? gv1 : gv0;
                            const u32x2 bw = bwv[i2][mt];
                            u32x2 ow;
                            ow.x = pk2(o[mt][it][0] * rstd * gv.x * pg8::silu_(bflo(bw.x)), o[mt][it][1] * rstd * gv.y * pg8::silu_(bfhi(bw.x)));
                            ow.y = pk2(o[mt][it][2] * rstd * gv.z * pg8::silu_(bflo(bw.y)), o[mt][it][3] * rstd * gv.w * pg8::silu_(bfhi(bw.y)));
                            *(u32x2*)(Hout + t * 2048 + 1024 + hh * 256 + dv0) = ow;
                        }
                    }
                }
            }
        }
#pragma unroll
        for (int mt = 0; mt < 8; ++mt) {
            const f32x4 sc = *(const LAS f32x4*)(L + GL_EBL + (16 * mt + 4 * g) * 4);
            bf16x8 ka[2];
#pragma unroll
            for (int kk = 0; kk < 2; ++kk) {
                const LAS unsigned char* kp = L + GL_KE + (32 * kk + 8 * g + q4) * GL_KST + (16 * mt + 4 * p4) * 2;
                const v4i16_t lo = vtr(kp), hi = vtr(kp + 4 * GL_KST);
                ka[kk] = __builtin_shufflevector(lo, hi, 0, 1, 2, 3, 4, 5, 6, 7);
            }
#pragma unroll
            for (int nt = 0; nt < 2; ++nt) {
                f32x4 sv = S[mt][nt] * sc;
#pragma unroll
                for (int kk = 0; kk < 2; ++kk) sv = MFMA16(ka[kk], vfr[kk][nt], sv);
                S[mt][nt] = sv;
            }
            __builtin_amdgcn_sched_barrier(0);
        }
    }
    if (MODE == 0) {
#pragma unroll
        for (int mt = 0; mt < 8; ++mt)
#pragma unroll
            for (int nt = 0; nt < 2; ++nt)
                { u32x2 pw; pw.x = cvtpk_s(S[mt][nt][0], S[mt][nt][1]); pw.y = cvtpk_s(S[mt][nt][2], S[mt][nt][3]); *(u32x2*)(sbase + (unsigned)((((mt * 2 + nt) * 8 + w) * 64 + (16 * g + c)) * 4)) = pw; }
        if (qr == 0) DG[(hh * 64 + grp) * 128 + dd] = __expf(lsum_d);
    }
    __syncthreads();
}

__constant__ float c_rope_inv[16] = {1.0f, 0.44036660267178046f, 0.19392274474868576f, 0.08539710028576561f, 0.03760603093086393f, 0.016560440080994446f, 0.007292664737217109f, 0.003211445994752591f,
                                     0.001414213562373095f, 0.000622772421914596f, 0.0002742481756762073f, 0.00012076973741146504f, 5.318295896944988e-05f, 2.341999896140934e-05f, 1.031338537721246e-05f, 4.5416704806078695e-06f};

__global__ void __launch_bounds__(NWAVES * 64, 2) fwd_megakernel(Args args) {
    extern __shared__ __attribute__((aligned(16))) unsigned char lds_raw[];
    cg::grid_group grid = cg::this_grid();
    Frame F;
    F.lds = (LAS unsigned char*)lds_raw;
    F.tid = threadIdx.x; F.lane = F.tid & 63; F.wave = __builtin_amdgcn_readfirstlane(F.tid >> 6);
    F.G = gridDim.x; F.gw = blockIdx.x * NWAVES + F.wave; F.NGW = F.G * NWAVES;
    unsigned char* ws = args.ws;
    volatile LAS unsigned* bar_st = (volatile LAS unsigned*)(F.lds + LDS_BYTES - 16);
    if (F.tid < 2) bar_st[F.tid] = 0u;
    __syncthreads();
    const XcdBarrier xbar = xcd_barrier_post((unsigned*)(ws + WS_BAR), bar_st);
    const float* x = args.in[0]; const int* positions = (const int*)args.in[1];
    float* out = args.out;
    bf16_t* Wgu = (bf16_t*)(ws + WS_WGU); bf16_t* Wd = (bf16_t*)(ws + WS_WD); bf16_t* Win = (bf16_t*)(ws + WS_WIN);
    bf16_t* WupA = (bf16_t*)(ws + WS_WUPA);
    bf16_t* Wout = (bf16_t*)(ws + WS_WOUT);
    bf16_t* H = (bf16_t*)(ws + WS_H); bf16_t* ACT = (bf16_t*)(ws + WS_ACT);
    bf16_t* QKVA = (bf16_t*)(ws + WS_QKVA); bf16_t* BB = (bf16_t*)(ws + WS_BB); unsigned char* GATES = (unsigned char*)(ws + WS_GATES);
    bf16_t* X1B = (bf16_t*)args.out;
    bf16_t* X2B = (bf16_t*)(ws + WS_X2B);
    float* BZ = (float*)(ws + WS_BZ);
    bf16_t* Y = (bf16_t*)(ws + WS_Y);

    {
        conv_matrix(F, args.in[3], FF, D, FF, 1, Wgu, 0);
        conv_matrix(F, args.in[4], FF, D, FF, 2, Wgu, 0);
        conv_matrix(F, args.in[5], D, FF, D, 0, Wd, 0);
        conv_matrix(F, args.in[7], 10256, D, NPROJ, 3, Win, 0);
        conv_matrix(F, args.in[13], D, AW, D, 0, WupA, 0, D);
        conv_matrix(F, args.in[14], D, AW, D, 0, WupA + 1024, 1024, D);
        conv_matrix(F, args.in[15], D, D, D, 0, Wout, 0);
        rms_rows_pipelined(F, x, args.in[2], H);
    }
    grid.sync();
    {
        pg8::Gemm g{H, Wgu, M, 2 * FF, D, D, D}; pg8::StaticOrder S; S.init(M, 2 * FF, F.G, (int)blockIdx.x);
        pg8::EpiSwiGLU E{ACT, FF};
        pg8::gemm_phase<pg8::EpiSwiGLU, true>(F.lds, g, S, E);
    }
    xcd_barrier(xbar);
    {
        pg8::Gemm g{ACT, Wd, M, D, FF, FF, FF}; pg8::StaticOrder S; S.init(M, D, F.G, (int)blockIdx.x, 4);
        pg8::EpiResidX<true, false> E{x, X1B, 0.5f};
        pg8::gemm_phase<pg8::EpiResidX<true, false>, true>(F.lds, g, S, E);
    }
    xcd_barrier(xbar);
    {
        LAS float* wz = (LAS float*)F.lds;
        const float* w_in = args.in[7];
        for (int e = F.tid; e < D * 16; e += NWAVES * 64) { const int k = e >> 4, j = e & 15; wz[j * D + k] = w_in[(size_t)k * 10256 + 6144 + j]; }
        __syncthreads();
        f32x4 gv[8], h0[8], h1[8]; load_gain(args.in[6], F.lane, gv);
        for (int m = F.gw; m < M; m += 2 * F.NGW) {
            const int m1 = m + F.NGW; const bool two = m1 < M;
            row_load(X1B + (size_t)m * D, F.lane, h0);
            if (two) row_load(X1B + (size_t)m1 * D, F.lane, h1);
            row_finish(h0, gv, H + (size_t)m * D, F.lane);
            if (two) row_finish(h1, gv, H + (size_t)m1 * D, F.lane);
            float mine0 = 0.f, mine1 = 0.f;
#pragma unroll 1
            for (int j = 0; j < 16; ++j) {
                float a0 = 0.f, a1 = 0.f;
#pragma unroll
                for (int i = 0; i < 8; ++i) { const f32x4 w = *(const LAS f32x4*)(wz + j * D + 256 * i + 4 * F.lane);
                    a0 += (h0[i].x * w.x + h0[i].y * w.y) + (h0[i].z * w.z + h0[i].w * w.w);
                    a1 += (h1[i].x * w.x + h1[i].y * w.y) + (h1[i].z * w.z + h1[i].w * w.w); }
                a0 = wave_sum(a0); a1 = wave_sum(a1);
                if (F.lane == j) { mine0 = a0; mine1 = a1; }
            }
            if (F.lane < 16) { BZ[(size_t)m * 16 + F.lane] = mine0; if (two) BZ[(size_t)m1 * 16 + F.lane] = mine1; }
        }
        __syncthreads();
    }
    xcd_barrier(xbar);
    {
        pg8::Gemm g{H, Win, M, NPROJ, D, D, D}; pg8::StaticOrder S; S.init(M, NPROJ, F.G, (int)blockIdx.x);
        pg8::EpiProj E{QKVA, BB, GATES};
        pg8::gemm_phase<pg8::EpiProj, true>(F.lds, g, S, E);
    }
    xcd_barrier(xbar);
    {
        const float* gq = args.in[8]; const float* gk = args.in[9]; const float* w2 = args.in[10]; const float* gb = args.in[11];
        const int lane = F.lane;
        for (int t = F.gw; t < M; t += F.NGW) {
            const float pos = (float)positions[t];
            unsigned* prow = (unsigned*)(QKVA + (size_t)t * 3072) + lane;
            unsigned wv[16];
#pragma unroll
            for (int v = 0; v < 16; ++v) wv[v] = prow[v * 64];
            float s0 = 0.f, c0 = 1.f, s1 = 0.f, c1 = 1.f;
            if (lane < 16) {
                const int i0 = (2 * lane) & 15;
                const float a0 = pos * c_rope_inv[i0], a1 = pos * c_rope_inv[i0 + 1];
                const double rv0 = (double)a0 * 0.15915494309189535, rv1 = (double)a1 * 0.15915494309189535;
                const float f0 = (float)(rv0 - rint(rv0)), f1 = (float)(rv1 - rint(rv1));
                s0 = __builtin_amdgcn_sinf(f0); c0 = __builtin_amdgcn_cosf(f0); s1 = __builtin_amdgcn_sinf(f1); c1 = __builtin_amdgcn_cosf(f1);
                if (lane < 8) { s0 = -s0; s1 = -s1; }
            }
            const float gq0 = gq[2 * lane], gq1 = gq[2 * lane + 1], gk0 = gk[2 * lane], gk1 = gk[2 * lane + 1];
#pragma unroll
            for (int v = 0; v < 16; ++v) {
                const float x0 = bflo(wv[v]), x1 = bfhi(wv[v]);
                const float ss = wave_sum(x0 * x0 + x1 * x1);
                const float r = 1.0f / sqrtf(ss * (1.0f / 128.0f) + RMS_EPS);
                float y0 = x0 * r * (v < 8 ? gq0 : gk0), y1 = x1 * r * (v < 8 ? gq1 : gk1);
                const float p0 = __shfl_xor(y0, 8), p1 = __shfl_xor(y1, 8);
                if (lane < 16) { y0 = y0 * c0 + p0 * s0; y1 = y1 * c1 + p1 * s1; }
                prow[v * 64] = pk2(y0, y1);
            }
        }
    }
    xcd_barrier(xbar);
    {
        bf16_t* OACC = (bf16_t*)(ws + WS_ORAW); float* LACC = (float*)ws;
        bf16_t* SLOC = (bf16_t*)(ws + WS_SLOC); float* DG = (float*)(ws + WS_DG);
        const float* gq = args.in[8]; const float* gk = args.in[9];
        const float mq = wave_max(fmaxf(fabsf(gq[2 * F.lane]), fabsf(gq[2 * F.lane + 1]))), mk = wave_max(fmaxf(fabsf(gk[2 * F.lane]), fabsf(gk[2 * F.lane + 1])));
        const float nb2 = -11.313708499f * mq * mk * 1.44269504089f;
        for (int it = blockIdx.x; it < 256; it += F.G) gla_item<0>(F, it >> 6, it & 63, BB, BZ, args.in[10], args.in[11], args.in[12], SLOC, DG, H);
        attn_pass<0>(F, QKVA, OACC, LACC, H, nb2);
        xcd_barrier(xbar);
        for (int e = blockIdx.x * 512 + F.tid; e < 4 * 128 * 256 / 2; e += F.G * 512) {
            const int hh = e >> 14, rem = (e & 16383) * 2, dk = 16 * (rem >> 12) + 4 * ((rem >> 6) & 3) + (rem & 3);
            float run0 = 0.f, run1 = 0.f;
#pragma unroll 1
            for (int g0 = 0; g0 < 64; g0 += 16) {
                unsigned tv[16]; f32x2 dv_[16];
#pragma unroll
                for (int u = 0; u < 16; ++u) { tv[u] = *(const unsigned*)(SLOC + (size_t)(hh * 64 + g0 + u) * 32768 + rem); dv_[u] = *(const f32x2*)(DG + (hh * 64 + g0 + u) * 128 + dk); }
#pragma unroll
                for (int u = 0; u < 16; ++u) { *(unsigned*)(SLOC + (size_t)(hh * 64 + g0 + u) * 32768 + rem) = cvtpk_s(run0, run1); run0 = dv_[u].x * run0 + bflo(tv[u]); run1 = dv_[u].y * run1 + bfhi(tv[u]); }
            }
        }
        attn_pass<1>(F, QKVA, OACC, LACC, H, nb2);
        xcd_barrier(xbar);
        for (int it = blockIdx.x; it < 256; it += F.G) gla_item<1>(F, it >> 6, it & 63, BB, BZ, args.in[10], args.in[11], args.in[12], SLOC, DG, H);
        attn_pass<2>(F, QKVA, OACC, LACC, H, nb2);
    }
    xcd_barrier(xbar);
    {
        pg8::StaticOrder S; S.init(M, D, F.G, (int)blockIdx.x, 4);
        pg8::Gemm g{H, WupA, M, D, D, D, D}; pg8::EpiGateY E{GATES, Y}; pg8::GateMid HK{GATES};
        pg8::gemm_phase<pg8::EpiGateY, true, pg8::GateMid>(F.lds, g, S, E, HK);
    }
    xcd_barrier(xbar);
    {
        pg8::Gemm g{Y, Wout, M, D, D, D, D}; pg8::StaticOrder S; S.init(M, D, F.G, (int)blockIdx.x, 4);
        pg8::EpiResidX<false, false> E{X1B, X2B, 1.0f};
        pg8::gemm_phase<pg8::EpiResidX<false, false>, true>(F.lds, g, S, E);
    }
    xcd_barrier(xbar);
    {
        conv_matrix(F, args.in[17], FF, D, FF, 1, Wgu, 0);
        conv_matrix(F, args.in[18], FF, D, FF, 2, Wgu, 0);
        conv_matrix(F, args.in[19], D, FF, D, 0, Wd, 0);
        rms_rows_pipelined(F, X2B, args.in[16], H);
    }
    xcd_barrier(xbar);
    {
        pg8::Gemm g{H, Wgu, M, 2 * FF, D, D, D}; pg8::StaticOrder S; S.init(M, 2 * FF, F.G, (int)blockIdx.x);
        pg8::EpiSwiGLU E{ACT, FF};
        pg8::gemm_phase<pg8::EpiSwiGLU, true>(F.lds, g, S, E);
    }
    xcd_barrier(xbar);
    {
        pg8::Gemm g{ACT, Wd, M, D, FF, FF, FF}; pg8::StaticOrder S; S.init(M, D, F.G, (int)blockIdx.x, 4);
        pg8::EpiResidX<false, true> E{X2B, out, 0.5f};
        pg8::gemm_phase<pg8::EpiResidX<false, true>, true>(F.lds, g, S, E);
    }
}

extern "C" void kernel_launch(void* const* d_in, const int* in_sizes, int n_in, void* d_out, int out_size, void* d_ws, size_t ws_size, hipStream_t stream) {
    static int grid = 0;
    if (grid == 0) {
        if (n_in != 20 || in_sizes[0] != M * D || out_size != M * D || ws_size < WS_END) { fprintf(stderr, "kernel_launch: unexpected shapes / workspace (n_in %d, ws %zu)\n", n_in, ws_size); grid = -1; return; }
        int dev = 0, cus = 0, per_cu = 0;
        (void)hipGetDevice(&dev); (void)hipDeviceGetAttribute(&cus, hipDeviceAttributeMultiprocessorCount, dev);
        if (hipFuncSetAttribute((const void*)fwd_megakernel, hipFuncAttributeMaxDynamicSharedMemorySize, LDS_BYTES) != hipSuccess) { fprintf(stderr, "kernel_launch: hipFuncSetAttribute failed\n"); grid = -1; return; }
        if (hipOccupancyMaxActiveBlocksPerMultiprocessor(&per_cu, (const void*)fwd_megakernel, NWAVES * 64, LDS_BYTES) != hipSuccess || per_cu < 1) { fprintf(stderr, "kernel_launch: occupancy query says %d\n", per_cu); (void)hipGetLastError(); }
        grid = cus;
    }
    if (grid < 0) return;
    if (hipMemsetAsync((char*)d_ws + WS_BAR, 0, 16384, stream) != hipSuccess) { fprintf(stderr, "kernel_launch: memset failed\n"); return; }
    Args a{};
    for (int i = 0; i < 20; ++i) a.in[i] = (const float*)d_in[i];
    a.out = (float*)d_out; a.ws = (unsigned char*)d_ws;
    void* kargs[] = {&a};
    hipError_t e = hipLaunchCooperativeKernel((const void*)fwd_megakernel, dim3(grid), dim3(NWAVES * 64), kargs, LDS_BYTES, stream);
    if (e != hipSuccess) fprintf(stderr, "cooperative launch failed: %s (grid %d)\n", hipGetErrorString(e), grid);
}
```

```cpp
#include <hip/hip_runtime.h>
#include <hip/hip_cooperative_groups.h>
#include <cstdio>
#include <cstdint>
namespace cg = cooperative_groups;

#define LAS __attribute__((address_space(3)))
typedef unsigned short bf16_t;
typedef short bf16x8 __attribute__((ext_vector_type(8)));
typedef float f32x4 __attribute__((ext_vector_type(4)));
typedef float f32x2 __attribute__((ext_vector_type(2)));
typedef unsigned u32x4 __attribute__((ext_vector_type(4)));
typedef unsigned u32x2 __attribute__((ext_vector_type(2)));

constexpr int M = 16384, D = 2048, FF = 5632;
constexpr int NPROJ = 10240;
constexpr int AW = 1024;
constexpr float RMS_EPS = 1e-6f;
constexpr int NWAVES = 8;

constexpr size_t MiB = 1u << 20;
constexpr size_t WS_SS1 = 512 * 1024;
constexpr size_t WS_BAR = 768 * 1024;
constexpr size_t WS_BZ = 1 * MiB;
constexpr size_t WS_WGU = 2 * MiB;
constexpr size_t WS_WD = 46 * MiB;
constexpr size_t WS_ORAW = 2 * MiB;
constexpr size_t WS_Y = 2 * MiB;
constexpr size_t WS_WIN = 68 * MiB;
constexpr size_t WS_SLOC = 68 * MiB;
constexpr size_t WS_DG = 100 * MiB;
constexpr size_t WS_WUPA = 108 * MiB, WS_WUPB = 112 * MiB;
constexpr size_t WS_WOUT = 116 * MiB;
constexpr size_t WS_H = 124 * MiB;
constexpr size_t WS_QKVA = 188 * MiB;
constexpr size_t WS_BB = 284 * MiB;
constexpr size_t WS_GATES = 380 * MiB;
constexpr size_t WS_ACT = 188 * MiB;
constexpr size_t WS_T = 188 * MiB;
constexpr size_t WS_X2B = 380 * MiB;
constexpr size_t WS_END = 508 * MiB;

constexpr int LDS_BYTES = 147456;

__device__ __forceinline__ unsigned f2bf(float f) { unsigned u = __builtin_bit_cast(unsigned, f); return (u + 0x7fffu + ((u >> 16) & 1u)) >> 16; }
__device__ __forceinline__ unsigned pk2(float lo, float hi) { return f2bf(lo) | (f2bf(hi) << 16); }
__device__ __forceinline__ float bf2f(unsigned short b) { return __builtin_bit_cast(float, (unsigned)b << 16); }
__device__ __forceinline__ float bflo(unsigned w) { return __builtin_bit_cast(float, w << 16); }
__device__ __forceinline__ float bfhi(unsigned w) { return __builtin_bit_cast(float, w & 0xffff0000u); }
__device__ __forceinline__ float wave_sum(float v) {
#pragma unroll
    for (int o = 1; o < 64; o <<= 1) v += __shfl_xor(v, o);
    return v;
}
__device__ __forceinline__ float wave_max(float v) {
#pragma unroll
    for (int o = 1; o < 64; o <<= 1) v = fmaxf(v, __shfl_xor(v, o));
    return v;
}
__device__ __forceinline__ float sigmoidf_(float x) { return __builtin_amdgcn_rcpf(1.0f + __builtin_amdgcn_exp2f(-1.44269504089f * x)); }

namespace pg8 {
constexpr int BM = 256, BK = 64, HALF = 128, HTB = HALF * BK * 2, STAGE_BYTES = 8 * HTB, NXCD = 8;
__host__ __device__ __forceinline__ int lds_byte(int r, int c) { const int st = (r >> 4) * 2 + (c >> 5), rr = r & 15, cc = c & 31, ob = rr * 64 + cc * 2; return st * 1024 + (ob ^ (((ob >> 9) & 1) << 5)); }
__host__ __device__ __forceinline__ void stage_rc(int b, int& R, int& C) { const int st = b / 1024, sb = b % 1024, swz = sb ^ (((sb >> 9) & 1) << 5); R = (st >> 1) * 16 + swz / 64; C = (st & 1) * 32 + (swz % 64) / 2; }
__host__ __device__ __forceinline__ int perm32(int rho) { const int n = rho >> 4, i = rho & 15; return 8 * (i >> 2) + 4 * n + (i & 3); }

struct Unit { int pm, pn; };
struct Gemm { const bf16_t* A; const bf16_t* Bt; int M, N, K, lda, ldb; };

struct StaticOrder {
    int nM, nN, nwg, G, c, WGM;
    __host__ __device__ void init(int M_, int N_, int G_, int c_, int wgm = 8) { nM = M_ / BM; nN = N_ / BM; nwg = nM * nN; G = G_; c = c_; WGM = wgm; }
    __host__ __device__ bool next(int i, Unit& u) const {
        const long L = (long)i * G + c; if (L >= nwg) return false;
        int wgid = (int)L; { const int q = nwg / NXCD, r = nwg % NXCD, xcd = wgid % NXCD, off = wgid / NXCD; wgid = (xcd < r ? xcd * (q + 1) : r * (q + 1) + (xcd - r) * q) + off; }
        const int nig = WGM * nN, gid = wgid / nig, fm = gid * WGM, gsz = (nM - fm) < WGM ? (nM - fm) : WGM;
        u.pm = fm + ((wgid % nig) % gsz); u.pn = (wgid % nig) / gsz; return true;
    }
};

__device__ __forceinline__ unsigned cvt_pk_bf16(float lo, float hi) { unsigned r; asm volatile("v_cvt_pk_bf16_f32 %0, %1, %2" : "=v"(r) : "v"(lo), "v"(hi)); return r; }

__device__ __forceinline__ float silu_(float g) { return g * __builtin_amdgcn_rcpf(1.0f + __builtin_amdgcn_exp2f(-1.44269504089f * g)); }
__device__ __forceinline__ f32x2 silu_mul_pk(f32x2 g, f32x2 u) {
    const f32x2 t = g * (-1.44269504089f);
    f32x2 e; e.x = __builtin_amdgcn_exp2f(t.x); e.y = __builtin_amdgcn_exp2f(t.y);
    const f32x2 dd = e + 1.0f;
    f32x2 r; r.x = __builtin_amdgcn_rcpf(dd.x); r.y = __builtin_amdgcn_rcpf(dd.y);
    return (g * r) * u;
}
__device__ __forceinline__ f32x2 sigmoid_pk(f32x2 g) {
    const f32x2 t = g * (-1.44269504089f);
    f32x2 e; e.x = __builtin_amdgcn_exp2f(t.x); e.y = __builtin_amdgcn_exp2f(t.y);
    const f32x2 dd = e + 1.0f;
    f32x2 r; r.x = __builtin_amdgcn_rcpf(dd.x); r.y = __builtin_amdgcn_rcpf(dd.y);
    return r;
}

struct EpiSwiGLU {
    static constexpr bool PERM = true;
    bf16_t* O; int ldc; const float* ss;
    __device__ __forceinline__ void operator()(const f32x4 (&acc)[2][2][4][2], const Unit& u, int wr, int wc, int fr, int fq) const {
        const int row0 = u.pm * BM + wr * 64 + fr; const int col0 = u.pn * HALF + wc * 32 + 8 * fq;
        float rs[2][4];
#pragma unroll
        for (int ai = 0; ai < 2; ++ai)
#pragma unroll
            for (int m = 0; m < 4; ++m) rs[ai][m] = ss ? ss[row0 + ai * HALF + m * 16] : 0.f;
#pragma unroll
        for (int ai = 0; ai < 2; ++ai)
#pragma unroll
            for (int m = 0; m < 4; ++m) rs[ai][m] = ss ? 1.0f / sqrtf(rs[ai][m] * (1.0f / 2048.0f) + 1e-6f) : 1.0f;
#pragma unroll
        for (int ai = 0; ai < 2; ++ai)
#pragma unroll
            for (int m = 0; m < 4; ++m) {
                bf16_t* rowp = O + (size_t)(row0 + ai * HALF + m * 16) * ldc + col0;
                const float r_ = rs[ai][m];
                const f32x4 g0 = acc[ai][0][m][0] * r_, g1 = acc[ai][0][m][1] * r_, u0 = acc[ai][1][m][0] * r_, u1 = acc[ai][1][m][1] * r_;
                const f32x2 a = silu_mul_pk((f32x2){g0[0], g0[1]}, (f32x2){u0[0], u0[1]}), b = silu_mul_pk((f32x2){g0[2], g0[3]}, (f32x2){u0[2], u0[3]});
                const f32x2 c = silu_mul_pk((f32x2){g1[0], g1[1]}, (f32x2){u1[0], u1[1]}), d = silu_mul_pk((f32x2){g1[2], g1[3]}, (f32x2){u1[2], u1[3]});
                u32x4 w; w.x = cvt_pk_bf16(a.x, a.y); w.y = cvt_pk_bf16(b.x, b.y); w.z = cvt_pk_bf16(c.x, c.y); w.w = cvt_pk_bf16(d.x, d.y);
                *(u32x4*)rowp = w;
            }
    }
};
struct EpiResid {
    static constexpr bool PERM = false;
    const float* base; float* out; int ldc; float scale;
    __device__ __forceinline__ void operator()(const f32x4 (&acc)[2][2][4][2], const Unit& u, int wr, int wc, int fr, int fq) const {
        const int col0 = u.pn * BM + wc * 32 + 4 * fq;
#pragma unroll
        for (int ai = 0; ai < 2; ++ai) {
            f32x4 pre[4][2][2];
#pragma unroll
            for (int m = 0; m < 4; ++m) {
                const size_t off = (size_t)(u.pm * BM + ai * HALF + wr * 64 + m * 16 + fr) * ldc + col0;
#pragma unroll
                for (int bj = 0; bj < 2; ++bj)
#pragma unroll
                    for (int n = 0; n < 2; ++n) pre[m][bj][n] = *(const f32x4*)(base + off + bj * HALF + n * 16);
            }
#pragma unroll
            for (int m = 0; m < 4; ++m) {
                const size_t off = (size_t)(u.pm * BM + ai * HALF + wr * 64 + m * 16 + fr) * ldc + col0;
#pragma unroll
                for (int bj = 0; bj < 2; ++bj)
#pragma unroll
                    for (int n = 0; n < 2; ++n) *(f32x4*)(out + off + bj * HALF + n * 16) = pre[m][bj][n] + acc[ai][bj][m][n] * scale;
            }
        }
    }
};
template <bool IN_F32, bool OUT_F32> struct EpiResidX {
    static constexpr bool PERM = true;
    const void* base; void* out; float scale;
    __device__ __forceinline__ void operator()(const f32x4 (&acc)[2][2][4][2], const Unit& u, int wr, int wc, int fr, int fq) const {
        const int row0 = u.pm * BM + wr * 64 + fr; const int col0 = u.pn * BM + wc * 32 + 8 * fq;
#pragma unroll
        for (int ai = 0; ai < 2; ++ai) {
            f32x4 p0[4][2], p1[4][2];
#pragma unroll
            for (int m = 0; m < 4; ++m)
#pragma unroll
                for (int bj = 0; bj < 2; ++bj) {
                    const size_t e = (size_t)(row0 + ai * HALF + m * 16) * 2048 + col0 + bj * HALF;
                    if (IN_F32) { p0[m][bj] = *(const f32x4*)((const float*)base + e); p1[m][bj] = *(const f32x4*)((const float*)base + e + 4); }
                    else { const u32x4 w = *(const u32x4*)((const bf16_t*)base + e); p0[m][bj] = (f32x4){bflo(w.x), bfhi(w.x), bflo(w.y), bfhi(w.y)}; p1[m][bj] = (f32x4){bflo(w.z), bfhi(w.z), bflo(w.w), bfhi(w.w)}; }
                }
#pragma unroll
            for (int m = 0; m < 4; ++m)
#pragma unroll
                for (int bj = 0; bj < 2; ++bj) {
                    const size_t e = (size_t)(row0 + ai * HALF + m * 16) * 2048 + col0 + bj * HALF;
                    const f32x4 v0 = p0[m][bj] + acc[ai][bj][m][0] * scale, v1 = p1[m][bj] + acc[ai][bj][m][1] * scale;
                    if (OUT_F32) { *(f32x4*)((float*)out + e) = v0; *(f32x4*)((float*)out + e + 4) = v1; }
                    else { u32x4 w; w.x = cvt_pk_bf16(v0[0], v0[1]); w.y = cvt_pk_bf16(v0[2], v0[3]); w.z = cvt_pk_bf16(v1[0], v1[1]); w.w = cvt_pk_bf16(v1[2], v1[3]); *(u32x4*)((bf16_t*)out + e) = w; }
                }
        }
    }
};
__device__ __forceinline__ unsigned qbyte(float sgm) { const float t = fminf(sgm * 256.0f, 255.0f); return (unsigned)t; }
__device__ __forceinline__ float ubyte(unsigned w, int k) { return (float)((w >> (8 * k)) & 0xffu); }
struct EpiProj {
    static constexpr bool PERM = true;
    bf16_t* qkva; bf16_t* bb; unsigned char* gates;
    __device__ __forceinline__ void operator()(const f32x4 (&acc)[2][2][4][2], const Unit& u, int wr, int wc, int fr, int fq) const {
        bf16_t* base = qkva; int ldc = 3072, colt; bool sg = false;
        if (u.pn < 12) { colt = u.pn * BM; } else if (u.pn < 24) { base = bb; colt = (u.pn - 12) * BM; } else { colt = (u.pn - 24) * BM; sg = true; }
        const int row0 = u.pm * BM + wr * 64 + fr; const int col0 = colt + wc * 32 + 8 * fq;
#pragma unroll
        for (int ai = 0; ai < 2; ++ai)
#pragma unroll
            for (int m = 0; m < 4; ++m) {
                bf16_t* rowp = base + (size_t)(row0 + ai * HALF + m * 16) * ldc + col0;
#pragma unroll
                for (int bj = 0; bj < 2; ++bj) {
                    f32x4 v0 = acc[ai][bj][m][0], v1 = acc[ai][bj][m][1];
                    if (sg) {
                        const f32x2 a = sigmoid_pk((f32x2){v0[0], v0[1]}), b = sigmoid_pk((f32x2){v0[2], v0[3]}), c = sigmoid_pk((f32x2){v1[0], v1[1]}), d = sigmoid_pk((f32x2){v1[2], v1[3]});
                        u32x2 qw;
                        qw.x = qbyte(a.x) | (qbyte(a.y) << 8) | (qbyte(b.x) << 16) | (qbyte(b.y) << 24);
                        qw.y = qbyte(c.x) | (qbyte(c.y) << 8) | (qbyte(d.x) << 16) | (qbyte(d.y) << 24);
                        *(u32x2*)(gates + (size_t)(row0 + ai * HALF + m * 16) * 4096 + col0 + bj * HALF) = qw;
                        continue;
                    }
                    u32x4 w; w.x = cvt_pk_bf16(v0[0], v0[1]); w.y = cvt_pk_bf16(v0[2], v0[3]); w.z = cvt_pk_bf16(v1[0], v1[1]); w.w = cvt_pk_bf16(v1[2], v1[3]);
                    *(u32x4*)(rowp + bj * HALF) = w;
                }
            }
    }
};
struct NoHook { static constexpr int AT = -1; __device__ __forceinline__ void operator()(f32x4 (&)[2][2][4][2], const Unit&, int, int, int, int) const {} };
struct GateMid {
    static constexpr int AT = 16;
    const unsigned char* G;
    __device__ __forceinline__ void operator()(f32x4 (&acc)[2][2][4][2], const Unit& u, int wr, int wc, int fr, int fq) const {
        asm volatile("" : "+v"(fr), "+v"(fq));
        const int row0 = u.pm * BM + wr * 64 + fr; const int col0 = u.pn * BM + wc * 32 + 8 * fq;
        const unsigned char* gp = G + (size_t)row0 * 4096 + col0;
#pragma unroll
        for (int ai = 0; ai < 2; ++ai) {
            u32x2 ga[4][2], gb[4][2];
#pragma unroll
            for (int m = 0; m < 4; ++m)
#pragma unroll
                for (int bj = 0; bj < 2; ++bj) { const unsigned r = (unsigned)(ai * HALF + m * 16) * 4096u; ga[m][bj] = *(const u32x2*)(gp + r + bj * HALF); gb[m][bj] = *(const u32x2*)(gp + r + 2048 + bj * HALF); }
            asm volatile("" ::: "memory");
#pragma unroll
            for (int m = 0; m < 4; ++m)
#pragma unroll
                for (int bj = 0; bj < 2; ++bj) {
                    const u32x2 a = ga[m][bj], b = gb[m][bj];
                    f32x4 v0 = acc[ai][bj][m][0], v1 = acc[ai][bj][m][1];
#pragma unroll
                    for (int k = 0; k < 4; ++k) {
                        v0[k] *= (ubyte(a.x, k) + 0.5f) * __builtin_amdgcn_rcpf(ubyte(b.x, k) + 0.5f);
                        v1[k] *= (ubyte(a.y, k) + 0.5f) * __builtin_amdgcn_rcpf(ubyte(b.y, k) + 0.5f);
                    }
                    acc[ai][bj][m][0] = v0; acc[ai][bj][m][1] = v1;
                }
            asm volatile("" ::: "memory");
        }
    }
};
struct EpiGateY {
    static constexpr bool PERM = true;
    const unsigned char* G; bf16_t* Y;
    __device__ __forceinline__ void operator()(const f32x4 (&acc)[2][2][4][2], const Unit& u, int wr, int wc, int fr, int fq) const {
        const int row0 = u.pm * BM + wr * 64 + fr; const int col0 = u.pn * BM + wc * 32 + 8 * fq;
#pragma unroll
        for (int ai = 0; ai < 2; ++ai) {
            u32x2 gpre[4][2];
#pragma unroll
            for (int m = 0; m < 4; ++m)
#pragma unroll
                for (int bj = 0; bj < 2; ++bj) gpre[m][bj] = *(const u32x2*)(G + (size_t)(row0 + ai * HALF + m * 16) * 4096 + 2048 + col0 + bj * HALF);
#pragma unroll
            for (int m = 0; m < 4; ++m) {
                const size_t r = (size_t)(row0 + ai * HALF + m * 16);
#pragma unroll
                for (int bj = 0; bj < 2; ++bj) {
                    const u32x2 g = gpre[m][bj];
                    f32x4 v0 = acc[ai][bj][m][0], v1 = acc[ai][bj][m][1];
#pragma unroll
                    for (int k = 0; k < 4; ++k) { v0[k] *= (ubyte(g.x, k) + 0.5f) * (1.0f / 256.0f); v1[k] *= (ubyte(g.y, k) + 0.5f) * (1.0f / 256.0f); }
                    u32x4 w; w.x = cvt_pk_bf16(v0[0], v0[1]); w.y = cvt_pk_bf16(v0[2], v0[3]); w.z = cvt_pk_bf16(v1[0], v1[1]); w.w = cvt_pk_bf16(v1[2], v1[3]);
                    *(u32x4*)(Y + r * 2048 + col0 + bj * HALF) = w;
                }
            }
        }
    }
};

template <class Epi, bool ALIGN_EPI, class Hook = NoHook>
__device__ __forceinline__ void gemm_phase(LAS unsigned char* lds, const Gemm g, const StaticOrder& S, const Epi& E, const Hook& HK = Hook()) {
    int tid = threadIdx.x; asm volatile("" : "+v"(tid));
    const int wid = __builtin_amdgcn_readfirstlane(tid >> 6), lane = tid & 63, wr = wid >> 2, wc = wid & 3, fr = lane & 15, fq = lane >> 4;
    const int K = g.K, nt = K / BK;
    unsigned voffA[2], voffB[2];
#pragma unroll
    for (int i = 0; i < 2; ++i) { int R, C; stage_rc(tid * 16 + i * 8192, R, C); const int Rb = Epi::PERM ? ((R & ~31) + perm32(R & 31)) : R;
        voffA[i] = (unsigned)(R * g.lda + C) * 2u; voffB[i] = (unsigned)(Rb * g.ldb + C) * 2u; }
    const size_t kstep = (size_t)(BK * 2);
    const size_t hstepA = (size_t)HALF * g.lda * 2, hstepB = (size_t)HALF * g.ldb * 2;
    const size_t tstepA = 2 * hstepA, tstepB = 2 * hstepB;
    const unsigned ldsw = (unsigned)wid * 1024u;
    const int aoff = lds_byte(wr * 64 + fr, fq * 8), boff = lds_byte(wc * 32 + fr, fq * 8);
#define PG8_SA(b, h) (((b) * 2 + (h)) * HTB)
#define PG8_SB(b, h) ((4 + (b) * 2 + (h)) * HTB)
#define PG8_STAGE(bufoff, gbase, voff) do { _Pragma("unroll") for (int _i = 0; _i < 2; ++_i) \
        __builtin_amdgcn_global_load_lds((const unsigned*)((const char*)(gbase) + (voff)[_i]), (LAS unsigned*)(lds + (bufoff) + ldsw + _i * 8192), 16, 0, 0); } while (0)
#define PG8_LDA(dst, b, h) do { _Pragma("unroll") for (int m = 0; m < 4; ++m) _Pragma("unroll") for (int k = 0; k < 2; ++k) dst[m][k] = *(const LAS bf16x8*)(lds + PG8_SA(b, h) + aoff + m * 2048 + k * 1024); } while (0)
#define PG8_LDB(dst, b, h) do { _Pragma("unroll") for (int n = 0; n < 2; ++n) _Pragma("unroll") for (int k = 0; k < 2; ++k) dst[n][k] = *(const LAS bf16x8*)(lds + PG8_SB(b, h) + boff + n * 2048 + k * 1024); } while (0)
#define PG8_MMA(ai, bj, At, Bt) do { __builtin_amdgcn_s_setprio(1); _Pragma("unroll") for (int m = 0; m < 4; ++m) _Pragma("unroll") for (int n = 0; n < 2; ++n) _Pragma("unroll") for (int k = 0; k < 2; ++k) \
        acc[ai][bj][m][n] = __builtin_amdgcn_mfma_f32_16x16x32_bf16(Bt[n][k], At[m][k], acc[ai][bj][m][n], 0, 0, 0); __builtin_amdgcn_s_setprio(0); } while (0)
#define PG8_WAIT_V(n) asm volatile("s_waitcnt vmcnt(" #n ")" ::: "memory")
#define PG8_WAIT_L(n) asm volatile("s_waitcnt lgkmcnt(" #n ")" ::: "memory")
#define PG8_BAR __builtin_amdgcn_s_barrier()
#define PG8_SCHED __builtin_amdgcn_sched_barrier(0)
    Unit cur, nxt; int ui = 0;
    if (!S.next(0, cur)) return;
    f32x4 acc[2][2][4][2];
#pragma unroll
    for (int a = 0; a < 2; ++a)
#pragma unroll
        for (int b = 0; b < 2; ++b)
#pragma unroll
            for (int m = 0; m < 4; ++m)
#pragma unroll
                for (int n = 0; n < 2; ++n) acc[a][b][m][n] = (f32x4){0.f, 0.f, 0.f, 0.f};
    bf16x8 At[4][2], B0[2][2], B1[2][2];
    const char* cA = (const char*)g.A + (size_t)cur.pm * tstepA; const char* cB = (const char*)g.Bt + (size_t)cur.pn * tstepB;
    PG8_STAGE(PG8_SB(0, 0), cB, voffB); PG8_STAGE(PG8_SB(0, 1), cB + hstepB, voffB); PG8_STAGE(PG8_SA(0, 0), cA, voffA); PG8_STAGE(PG8_SA(0, 1), cA + hstepA, voffA);
    if (wr == 1) PG8_BAR;
    PG8_WAIT_V(2); PG8_BAR;
    PG8_STAGE(PG8_SB(1, 0), cB + kstep, voffB); PG8_STAGE(PG8_SA(1, 0), cA + kstep, voffA); PG8_STAGE(PG8_SB(1, 1), cB + hstepB + kstep, voffB);
    PG8_WAIT_V(6); PG8_BAR;
    for (;;) {
        const bool has_next = S.next(ui + 1, nxt);
        const char* nA = has_next ? (const char*)g.A + (size_t)nxt.pm * tstepA : cA; const char* nB = has_next ? (const char*)g.Bt + (size_t)nxt.pn * tstepB : cB;
        for (int t = 0; t < nt; t += 2) {
            if (Hook::AT > 0 && t == Hook::AT) HK(acc, cur, wr, wc, fr, fq);
            const bool last = (t == nt - 2);
            const char* a1 = cA + (size_t)(t + 1) * kstep;
            const char* a2 = last ? nA : cA + (size_t)(t + 2) * kstep; const char* b2 = last ? nB : cB + (size_t)(t + 2) * kstep;
            const char* a3 = a2 + kstep; const char* b3 = b2 + kstep;
            PG8_LDB(B0, 0, 0); PG8_LDB(B1, 0, 1); PG8_SCHED; PG8_LDA(At, 0, 0); PG8_STAGE(PG8_SA(1, 1), a1 + hstepA, voffA);
            PG8_WAIT_V(8); PG8_WAIT_L(0); PG8_BAR; PG8_MMA(0, 0, At, B0); PG8_MMA(0, 1, At, B1); PG8_BAR; PG8_SCHED;
            PG8_LDA(At, 0, 1); PG8_STAGE(PG8_SB(0, 0), b2, voffB); PG8_STAGE(PG8_SB(0, 1), b2 + hstepB, voffB); PG8_STAGE(PG8_SA(0, 0), a2, voffA);
            PG8_WAIT_V(8); PG8_WAIT_L(0); PG8_BAR; PG8_MMA(1, 0, At, B0); PG8_MMA(1, 1, At, B1); PG8_BAR; PG8_SCHED;
            PG8_LDB(B0, 1, 0); PG8_LDB(B1, 1, 1); PG8_SCHED; PG8_LDA(At, 1, 0); PG8_STAGE(PG8_SA(0, 1), a2 + hstepA, voffA);
            PG8_WAIT_V(8); PG8_WAIT_L(0); PG8_BAR; PG8_MMA(0, 0, At, B0); PG8_MMA(0, 1, At, B1); PG8_BAR; PG8_SCHED;
            PG8_LDA(At, 1, 1); PG8_STAGE(PG8_SB(1, 0), b3, voffB); PG8_STAGE(PG8_SB(1, 1), b3 + hstepB, voffB); PG8_STAGE(PG8_SA(1, 0), a3, voffA);
            PG8_WAIT_V(8); PG8_WAIT_L(0); PG8_BAR; PG8_MMA(1, 0, At, B0); PG8_MMA(1, 1, At, B1); PG8_BAR; PG8_SCHED;
        }
        if constexpr (ALIGN_EPI) { if (wr == 0) PG8_BAR; }
        E(acc, cur, wr, wc, fr, fq);
        if (!has_next) break;
#pragma unroll
        for (int a = 0; a < 2; ++a)
#pragma unroll
            for (int b = 0; b < 2; ++b)
#pragma unroll
                for (int m = 0; m < 4; ++m)
#pragma unroll
                    for (int n = 0; n < 2; ++n) acc[a][b][m][n] = (f32x4){0.f, 0.f, 0.f, 0.f};
        cur = nxt; cA = nA; cB = nB; ++ui;
        if constexpr (ALIGN_EPI) { if (wr == 1) PG8_BAR; }
    }
    PG8_WAIT_V(0);
    if constexpr (!ALIGN_EPI) { if (wr == 0) PG8_BAR; }
    PG8_BAR;
#undef PG8_SA
#undef PG8_SB
#undef PG8_STAGE
#undef PG8_LDA
#undef PG8_LDB
#undef PG8_MMA
#undef PG8_WAIT_V
#undef PG8_WAIT_L
#undef PG8_BAR
#undef PG8_SCHED
}
}


#define XB_TMO      128
#define XB_XCNT(j)  (256  + 64 * (j))
#define XB_XSUB(j)  (1280 + 64 * (j))
#define XB_XGEN(j)  (2304 + 64 * (j))
#define XB_TOP      3328
#define XB_TOPGEN   3392
#define XCD_BAR_WORDS 3456
#define XB_SPIN_CAP (1u << 20)
__device__ __forceinline__ unsigned xb_ld(unsigned* p)              { return __hip_atomic_load(p, __ATOMIC_RELAXED, __HIP_MEMORY_SCOPE_AGENT); }
__device__ __forceinline__ unsigned xb_add(unsigned* p, unsigned v) { return __hip_atomic_fetch_add(p, v, __ATOMIC_RELAXED, __HIP_MEMORY_SCOPE_AGENT); }
__device__ __forceinline__ unsigned xb_xcc_id() { return (unsigned)__builtin_amdgcn_s_getreg((3 << 11) | 20) & 0xFu; }
#define XB_SPIN(cond, bar) do { unsigned _sp = 0; while (cond) { __builtin_amdgcn_s_sleep(1); \
    if ((++_sp & 255u) == 0u) { if (xb_ld(&(bar)[XB_TMO])) break; if (_sp > XB_SPIN_CAP) { atomicAdd(&(bar)[XB_TMO], 1u); break; } } } } while (0)
struct XcdBarrier { unsigned* bar; unsigned x; volatile LAS unsigned* st; };
__device__ __forceinline__ XcdBarrier xcd_barrier_post(unsigned* bar, volatile LAS unsigned* st) {
    XcdBarrier b; b.bar = bar; b.x = xb_xcc_id(); b.st = st;
    if (threadIdx.x == 0) (void)xb_add(&bar[XB_XCNT(b.x)], 1u);
    return b;
}
__device__ __forceinline__ void xcd_barrier_complete(unsigned* bar, unsigned x, unsigned& nloc, unsigned& nx) {
    const unsigned G = gridDim.x * gridDim.y * gridDim.z;
    unsigned sum, cnt, mine, sp = 0u;
    for (;;) {
        sum = 0u; cnt = 0u; mine = 0u;
#pragma unroll
        for (unsigned j = 0; j < 16; ++j) { const unsigned c = xb_ld(&bar[XB_XCNT(j)]); sum += c; cnt += (c > 0u) ? 1u : 0u; mine = (j == x) ? c : mine; }
        if (sum == G) break;
        __builtin_amdgcn_s_sleep(1);
        if ((++sp & 255u) == 0u) { if (xb_ld(&bar[XB_TMO])) break; if (sp > XB_SPIN_CAP) { atomicAdd(&bar[XB_TMO], 1u); break; } }
    }
    nloc = mine > 0u ? mine : 1u; nx = cnt > 0u ? cnt : 1u;
}
__device__ __forceinline__ void xcd_barrier(const XcdBarrier& b) {
    asm volatile("s_waitcnt vmcnt(0)" ::: "memory");
    __syncthreads();
    if (threadIdx.x == 0) {
        unsigned* bar = b.bar;
        __builtin_amdgcn_s_waitcnt(0);
        unsigned nloc = b.st[0], nx = b.st[1];
        if (nloc == 0u) { xcd_barrier_complete(bar, b.x, nloc, nx); b.st[0] = nloc; b.st[1] = nx; }
        const unsigned old = xb_add(&bar[XB_XSUB(b.x)], 1u);
        const unsigned gen = old / nloc;
        if (old + 1u == (gen + 1u) * nloc) {
            __builtin_amdgcn_fence(__ATOMIC_RELEASE, "agent");
            asm volatile("s_waitcnt vmcnt(0)" ::: "memory");
            const unsigned og = xb_add(&bar[XB_TOP], 1u);
            const unsigned tg = og / nx;
            if (og + 1u == (tg + 1u) * nx) xb_add(&bar[XB_TOPGEN], 1u);
            else XB_SPIN(xb_ld(&bar[XB_TOPGEN]) == tg, bar);
            __builtin_amdgcn_fence(__ATOMIC_ACQUIRE, "agent");
            xb_add(&bar[XB_XGEN(b.x)], 1u);
            asm volatile("s_waitcnt vmcnt(0)" ::: "memory");
        } else {
            XB_SPIN(xb_ld(&bar[XB_XGEN(b.x)]) == gen, bar);
            __builtin_amdgcn_fence(__ATOMIC_ACQUIRE, "agent");
            asm volatile("s_waitcnt vmcnt(0)" ::: "memory");
        }
    }
    __syncthreads();
}

struct Args { const float* in[20]; float* out; unsigned char* ws; };

struct Frame {
    LAS unsigned char* lds;
    int tid, lane, wave, G, gw, NGW;
};

__device__ __forceinline__ void transpose_item(const float* W, int ldw, int ldt, bf16_t* WT, int src_col0, int dst_row0, int k0, LAS float* scr, int lane, const float* gain) {
    float v[32];
    const float* wp = W + (size_t)(k0 + (lane >> 5)) * ldw + src_col0 + (lane & 31);
#pragma unroll
    for (int i = 0; i < 32; ++i) v[i] = wp[(size_t)(2 * i) * ldw];
#pragma unroll
    for (int i = 0; i < 32; ++i) { const int kk = 2 * i + (lane >> 5); scr[kk * 33 + (lane & 31)] = v[i]; }
    asm volatile("s_waitcnt lgkmcnt(0)" ::: "memory");
    const int c = lane & 7;
    f32x4 ga = (f32x4){1.f, 1.f, 1.f, 1.f}, gb = ga;
    if (gain) { ga = *(const f32x4*)(gain + k0 + 8 * c); gb = *(const f32x4*)(gain + k0 + 8 * c + 4); }
#pragma unroll
    for (int j = 0; j < 4; ++j) { const int n = (lane >> 3) + 8 * j; const LAS float* s = scr + (8 * c) * 33 + n;
        u32x4 o; o.x = pk2(s[0 * 33] * ga.x, s[1 * 33] * ga.y); o.y = pk2(s[2 * 33] * ga.z, s[3 * 33] * ga.w); o.z = pk2(s[4 * 33] * gb.x, s[5 * 33] * gb.y); o.w = pk2(s[6 * 33] * gb.z, s[7 * 33] * gb.w);
        *(u32x4*)(WT + (size_t)(dst_row0 + n) * ldt + k0 + 8 * c) = o; }
    asm volatile("s_waitcnt lgkmcnt(0)" ::: "memory");
}
__device__ __forceinline__ void conv_matrix(const Frame& F, const float* W, int ldw, int K, int ncols_dst, int mode, bf16_t* WT, int rot, int ldt = 0, const float* gain = nullptr) {
    if (ldt == 0) ldt = K;
    LAS float* scr = (LAS float*)(F.lds + F.wave * 16384);
    const int nblk = ncols_dst / 32, nitems = (K / 64) * nblk;
    int start = F.gw - rot; if (start < 0) start += F.NGW;
    for (int it = start; it < nitems; it += F.NGW) {
        const int kb = it / nblk, nb = it % nblk;
        int src = 32 * nb, dst = 32 * nb;
        if (mode == 1) dst = 256 * (nb >> 2) + 32 * (nb & 3);
        else if (mode == 2) dst = 256 * (nb >> 2) + 128 + 32 * (nb & 3);
        else if (mode == 3) src = 32 * nb + (32 * nb >= 6144 ? 16 : 0);
        transpose_item(W, ldw, ldt, WT, src, dst, 64 * kb, scr, F.lane, gain);
    }
}

__device__ __forceinline__ void load_gain(const float* gain, int lane, f32x4 (&gv)[8]) {
#pragma unroll
    for (int j = 0; j < 8; ++j) gv[j] = ((const f32x4*)gain + lane)[64 * j];
}
__device__ __forceinline__ void rms_row(const float* xrow, const f32x4 (&gv)[8], bf16_t* orow, int lane, f32x4 (&hv)[8]) {
    const f32x4* xr = (const f32x4*)xrow + lane;
    float s = 0.f;
#pragma unroll
    for (int j = 0; j < 8; ++j) { hv[j] = xr[64 * j]; s += (hv[j].x * hv[j].x + hv[j].y * hv[j].y) + (hv[j].z * hv[j].z + hv[j].w * hv[j].w); }
    const float r = 1.0f / sqrtf(wave_sum(s) * (1.0f / D) + RMS_EPS);
    u32x2* o8 = (u32x2*)orow + lane;
#pragma unroll
    for (int j = 0; j < 8; ++j) { hv[j] = hv[j] * r * gv[j]; u32x2 w; w.x = pk2(hv[j].x, hv[j].y); w.y = pk2(hv[j].z, hv[j].w); o8[64 * j] = w; }
}

__device__ __forceinline__ void row_load(const bf16_t* xrow, int lane, f32x4 (&xv)[8]) {
    const u32x2* xr = (const u32x2*)xrow + lane;
#pragma unroll
    for (int j = 0; j < 8; ++j) { const u32x2 w = xr[64 * j]; xv[j] = (f32x4){bflo(w.x), bfhi(w.x), bflo(w.y), bfhi(w.y)}; }
}
__device__ __forceinline__ void row_load(const float* xrow, int lane, f32x4 (&xv)[8]) {
    const f32x4* xr = (const f32x4*)xrow + lane;
#pragma unroll
    for (int j = 0; j < 8; ++j) xv[j] = xr[64 * j];
}
__device__ __forceinline__ void row_finish(f32x4 (&xv)[8], const f32x4 (&gv)[8], bf16_t* orow, int lane) {
    float s = 0.f;
#pragma unroll
    for (int j = 0; j < 8; ++j) s += (xv[j].x * xv[j].x + xv[j].y * xv[j].y) + (xv[j].z * xv[j].z + xv[j].w * xv[j].w);
    const float r = 1.0f / sqrtf(wave_sum(s) * (1.0f / D) + RMS_EPS);
    u32x2* o8 = (u32x2*)orow + lane;
#pragma unroll
    for (int j = 0; j < 8; ++j) { xv[j] = xv[j] * r * gv[j]; u32x2 w; w.x = pk2(xv[j].x, xv[j].y); w.y = pk2(xv[j].z, xv[j].w); o8[64 * j] = w; }
}
__device__ __forceinline__ void raw_rows_pipelined(const Frame& F, const float* X, bf16_t* Xb, float* ss) {
    f32x4 xa[8], xb[8];
    int m = F.gw;
    if (m < M) row_load(X + (size_t)m * D, F.lane, xa);
    for (; m < M; m += F.NGW) {
        const int mn = m + F.NGW;
        if (mn < M) row_load(X + (size_t)mn * D, F.lane, xb);
        float sq = 0.f;
        u32x2* o8 = (u32x2*)(Xb + (size_t)m * D) + F.lane;
#pragma unroll
        for (int j = 0; j < 8; ++j) { sq += (xa[j].x * xa[j].x + xa[j].y * xa[j].y) + (xa[j].z * xa[j].z + xa[j].w * xa[j].w); u32x2 w; w.x = pk2(xa[j].x, xa[j].y); w.y = pk2(xa[j].z, xa[j].w); o8[64 * j] = w; }
        sq = wave_sum(sq);
        if (F.lane == 0) ss[m] = sq;
#pragma unroll
        for (int j = 0; j < 8; ++j) xa[j] = xb[j];
    }
}
template <class XT>
__device__ __forceinline__ void rms_rows_pipelined(const Frame& F, const XT* X, const float* gain, bf16_t* Hout) {
    f32x4 gv[8], xa[8], xb[8]; load_gain(gain, F.lane, gv);
    int m = F.gw;
    if (m < M) row_load(X + (size_t)m * D, F.lane, xa);
    for (; m < M; m += F.NGW) {
        const int mn = m + F.NGW;
        if (mn < M) row_load(X + (size_t)mn * D, F.lane, xb);
        row_finish(xa, gv, Hout + (size_t)m * D, F.lane);
#pragma unroll
        for (int j = 0; j < 8; ++j) xa[j] = xb[j];
    }
}

typedef short v4i16_t __attribute__((ext_vector_type(4)));
typedef float f32x2_t __attribute__((ext_vector_type(2))); typedef __bf16 bf16x2_t __attribute__((ext_vector_type(2)));
__device__ __forceinline__ unsigned cvtpk_s(float lo, float hi) { f32x2_t v = {lo, hi}; bf16x2_t b = __builtin_convertvector(v, bf16x2_t); return __builtin_bit_cast(unsigned, b); }
__device__ __forceinline__ v4i16_t vtr(const LAS unsigned char* p) { return __builtin_amdgcn_ds_read_tr16_b64_v4i16((LAS v4i16_t*)p); }
#define MFMA16(a, b, c) __builtin_amdgcn_mfma_f32_16x16x32_bf16((a), (b), (c), 0, 0, 0)

template <int PASS>
__device__ __forceinline__ void attn_pass(const Frame& F, const bf16_t* QKVA, bf16_t* OACC, float* LACC, bf16_t* Hout, float nb2) {
    constexpr int d = 1 << (2 * PASS);
    constexpr int KST = 272, VST = 288;
    LAS unsigned char* Kl = F.lds; LAS unsigned char* Vl = F.lds + 256 * KST;
    int lane = F.lane; asm volatile("" : "+v"(lane));
    const int w = F.wave, g = lane >> 4, c = lane & 15, q4 = c >> 2, p4 = c & 3;
    constexpr float SCL = 0.08838834764831845f * 1.44269504089f;
    u32x4 kpre[8], vpre[8]; bf16x8 qpre[4];
    auto issue = [&](int idx) {
        const int h = idx & 7, blk = idx >> 3, r = blk % d, n = blk / d;
        { const size_t tqn = (size_t)(n * 128 + 16 * w + c) * d + r;
#pragma unroll
          for (int kk = 0; kk < 4; ++kk) qpre[kk] = *(const bf16x8*)(QKVA + tqn * 3072 + h * 128 + 8 * g + 32 * kk); }
#pragma unroll
        for (int u = 0; u < 8; ++u) {
            const int e = F.tid + 512 * u, row = e >> 4, ch = e & 15;
            int mrow = (n - 1) * 128 + row; if (mrow < 0) mrow = 0;
            const size_t t = (size_t)mrow * d + r;
            kpre[u] = *(const u32x4*)(QKVA + t * 3072 + 1024 + h * 128 + ch * 8);
            vpre[u] = *(const u32x4*)(QKVA + t * 3072 + 2048 + h * 128 + ch * 8);
        }
    };
    if ((int)blockIdx.x < 1024) issue(blockIdx.x);
    for (int idx = blockIdx.x; idx < 1024; idx += F.G) {
        const int h = idx & 7, blk = idx >> 3, r = blk % d, n = blk / d;
        __syncthreads();
#pragma unroll
        for (int u = 0; u < 8; ++u) {
            const int e = F.tid + 512 * u, row = e >> 4, ch = e & 15;
            *(LAS u32x4*)(Kl + row * KST + ch * 16) = kpre[u];
            *(LAS u32x4*)(Vl + row * VST + ch * 16) = vpre[u];
        }
        __syncthreads();
        bf16x8 qf[4];
#pragma unroll
        for (int kk = 0; kk < 4; ++kk) qf[kk] = qpre[kk];
        if (idx + F.G < 1024) issue(idx + F.G);
        const int qi = 16 * w + c;
        const size_t tq = (size_t)(n * 128 + qi) * d + r;
        f32x4 accO[8];
        bf16_t* op = OACC + tq * 1024 + h * 128 + 4 * g;
        float lsum = 0.f;
        if (PASS > 0) {
#pragma unroll
            for (int nt = 0; nt < 8; ++nt) { const u32x2 pv = *(const u32x2*)(op + 16 * nt); accO[nt] = (f32x4){bflo(pv.x), bfhi(pv.x), bflo(pv.y), bfhi(pv.y)}; }
            lsum = (g == 0) ? LACC[tq * 8 + h] : 0.f;
        } else {
#pragma unroll
            for (int nt = 0; nt < 8; ++nt) accO[nt] = (f32x4){0.f, 0.f, 0.f, 0.f};
        }
#pragma unroll 1
        for (int ks = 0; ks < 5; ++ks) {
            u32x4 pw;
#pragma unroll
            for (int half = 0; half < 2; ++half) {
                const int kt = w + 2 * ks + half; const int ktc = kt < 16 ? kt : 15;
                f32x4 sv = (f32x4){0.f, 0.f, 0.f, 0.f};
#pragma unroll
                for (int kk = 0; kk < 4; ++kk) { const bf16x8 a = *(const LAS bf16x8*)(Kl + (16 * ktc + c) * KST + (8 * g + 32 * kk) * 2); sv = MFMA16(a, qf[kk], sv); }
                float pj[4];
#pragma unroll
                for (int j = 0; j < 4; ++j) { const int kj = 16 * kt + 4 * g + j; const bool valid = (kj >= qi) && (kj <= qi + 128) && (n > 0 || kj >= 128);
                    pj[j] = valid ? __builtin_amdgcn_exp2f(sv[j] * SCL + nb2) : 0.f; lsum += pj[j]; }
                if (half == 0) { pw.x = cvtpk_s(pj[0], pj[1]); pw.y = cvtpk_s(pj[2], pj[3]); } else { pw.z = cvtpk_s(pj[0], pj[1]); pw.w = cvtpk_s(pj[2], pj[3]); }
            }
            const bf16x8 pa = __builtin_bit_cast(bf16x8, pw);
            const int kt0 = w + 2 * ks, kt1 = (kt0 + 1 < 16) ? kt0 + 1 : 15;
            const LAS unsigned char* v0 = Vl + (16 * kt0 + 4 * g + q4) * VST + 8 * p4;
            const LAS unsigned char* v1 = Vl + (16 * kt1 + 4 * g + q4) * VST + 8 * p4;
#pragma unroll
            for (int nt = 0; nt < 8; ++nt) {
                const v4i16_t lo = vtr(v0 + 32 * nt), hi = vtr(v1 + 32 * nt);
                const bf16x8 vf = __builtin_shufflevector(lo, hi, 0, 1, 2, 3, 4, 5, 6, 7);
                accO[nt] = MFMA16(vf, pa, accO[nt]);
            }
        }
        lsum += __shfl_xor(lsum, 16); lsum += __shfl_xor(lsum, 32);
        if (PASS < 2) {
#pragma unroll
            for (int nt = 0; nt < 8; ++nt) { u32x2 o; o.x = cvtpk_s(accO[nt][0], accO[nt][1]); o.y = cvtpk_s(accO[nt][2], accO[nt][3]); *(u32x2*)(op + 16 * nt) = o; }
            if (g == 0) LACC[tq * 8 + h] = lsum;
        } else {
            const float il = 1.0f / lsum;
            bf16_t* hp = Hout + tq * 2048 + h * 128 + 4 * g;
#pragma unroll
            for (int nt = 0; nt < 8; ++nt) { u32x2 o; o.x = cvtpk_s(accO[nt][0] * il, accO[nt][1] * il); o.y = cvtpk_s(accO[nt][2] * il, accO[nt][3] * il); *(u32x2*)(hp + 16 * nt) = o; }
        }
    }
    __syncthreads();
}

constexpr int GL_QT = 0, GL_KH = 17408, GL_KE = 34816, GL_V = 53248, GL_AM = 88064, GL_BZ = 97280, GL_TOT = 101376, GL_EBL = 103424, GL_RED = 103936, GL_CS = 105984;
constexpr int GL_ST = 272, GL_KST = 288, GL_VST = 544, GL_AST = 144;
template <int MODE>
__device__ __forceinline__ void gla_item(const Frame& F, int hh, int grp, const bf16_t* BB, const float* BZ, const float* w2g, const float* biasg, const float* gn, bf16_t* SLOC, float* DG, bf16_t* Hout) {
    LAS unsigned char* L = F.lds;
    const int tid = F.tid, lane = F.lane, w = F.wave; int g = lane >> 4, c = lane & 15; asm volatile("" : "+v"(g), "+v"(c));
    const int q4 = c >> 2, p4 = c & 3;
    const int dd = tid & 127, qr = tid >> 7;
    f32x4 S[8][2];
    bf16_t* sbase = SLOC + ((size_t)(hh * 64 + grp) * 128) * 256;
#pragma unroll
    for (int mt = 0; mt < 8; ++mt)
#pragma unroll
        for (int nt = 0; nt < 2; ++nt) {
            if (MODE == 0) S[mt][nt] = (f32x4){0.f, 0.f, 0.f, 0.f};
            else {
                { const u32x2 pw = *(const u32x2*)(sbase + (unsigned)((((mt * 2 + nt) * 8 + w) * 64 + (16 * g + c)) * 4)); S[mt][nt] = (f32x4){bflo(pw.x), bfhi(pw.x), bflo(pw.y), bfhi(pw.y)}; }
            }
        }
    float w2r[16];
#pragma unroll
    for (int r = 0; r < 16; ++r) w2r[r] = w2g[r * 512 + hh * 128 + dd];
    const float bias = biasg[hh * 128 + dd];
    float lsum_d = 0.f;
#pragma unroll 1
    for (int ch = 0; ch < 4; ++ch) {
        const int t0 = (grp * 4 + ch) * 64;
        __syncthreads();
        float* Bg = (float*)Hout + (size_t)t0 * 1024 + 512 + hh * 128 + dd;
        float bpre[16]; float total = 0.f;
        if (MODE == 0) { if (tid < 256) *(LAS f32x4*)(L + GL_BZ + tid * 16) = *(const f32x4*)(BZ + (size_t)t0 * 16 + tid * 4); }
        else {
#pragma unroll
            for (int ii = 0; ii < 16; ++ii) bpre[ii] = Bg[(size_t)(16 * qr + ii) * 1024];
            total = Bg[(size_t)63 * 1024];
        }
        {
            u32x4 vv[4], kv[2], qv[2];
#pragma unroll
            for (int u = 0; u < 4; ++u) { const int e = tid + 512 * u, row = e >> 5, cc = e & 31; vv[u] = *(const u32x4*)(BB + (size_t)(t0 + row) * 3072 + 1024 + hh * 256 + cc * 8); }
#pragma unroll
            for (int u = 0; u < 2; ++u) { const int e = tid + 512 * u, row = e >> 4, cc = e & 15; kv[u] = *(const u32x4*)(BB + (size_t)(t0 + row) * 3072 + 512 + hh * 128 + cc * 8);
                if (MODE == 1) qv[u] = *(const u32x4*)(BB + (size_t)(t0 + row) * 3072 + hh * 128 + cc * 8); }
#pragma unroll
            for (int u = 0; u < 4; ++u) { const int e = tid + 512 * u, row = e >> 5, cc = e & 31; *(LAS u32x4*)(L + GL_V + row * GL_VST + cc * 16) = vv[u]; }
#pragma unroll
            for (int u = 0; u < 2; ++u) { const int e = tid + 512 * u, row = e >> 4, cc = e & 15; *(LAS u32x4*)(L + GL_KE + row * GL_KST + cc * 16) = kv[u];
                if (MODE == 1) *(LAS u32x4*)(L + GL_QT + row * GL_ST + cc * 16) = qv[u]; }
        }
        __syncthreads();
        if (MODE == 0) {
            float run = 0.f;
            LAS float* csl = (LAS float*)(L + GL_CS);
#pragma unroll 2
            for (int ii = 0; ii < 16; ++ii) {
                const LAS float* bz = (const LAS float*)(L + GL_BZ) + (16 * qr + ii) * 16;
                float z = bias;
#pragma unroll
                for (int r = 0; r < 16; ++r) z += bz[r] * w2r[r];
                const float ls = -__logf(1.0f + __expf(-fmaxf(z, -80.f)));
                run += ls * (1.0f / 16.0f); csl[(16 * qr + ii) * 128 + dd] = run;
            }
            ((LAS float*)(L + GL_TOT))[qr * 128 + dd] = run;
            __syncthreads();
            float pre = 0.f;
#pragma unroll
            for (int qq = 0; qq < 4; ++qq) { const float tv = ((const LAS float*)(L + GL_TOT))[qq * 128 + dd]; total += tv; if (qq < qr) pre += tv; }
#pragma unroll 2
            for (int ii = 0; ii < 16; ++ii) {
                const int i = 16 * qr + ii; const float Bv = pre + csl[i * 128 + dd];
                Bg[(size_t)i * 1024] = Bv;
                const float kf = bf2f(*(const LAS bf16_t*)(L + GL_KE + i * GL_KST + dd * 2));
                *(LAS bf16_t*)(L + GL_KE + i * GL_KST + dd * 2) = (bf16_t)cvtpk_s(kf * __expf(total - Bv), 0.f);
            }
        } else {
#pragma unroll
            for (int ii = 0; ii < 16; ++ii) {
                const int i = 16 * qr + ii; const float Bv = bpre[ii];
                const float kf = bf2f(*(const LAS bf16_t*)(L + GL_KE + i * GL_KST + dd * 2));
                const float qf = bf2f(*(const LAS bf16_t*)(L + GL_QT + i * GL_ST + dd * 2));
                *(LAS bf16_t*)(L + GL_KE + i * GL_KST + dd * 2) = (bf16_t)cvtpk_s(kf * __expf(total - Bv), 0.f);
                *(LAS bf16_t*)(L + GL_QT + i * GL_ST + dd * 2) = (bf16_t)cvtpk_s(qf * 0.08838834764831845f * __expf(Bv), 0.f);
                *(LAS bf16_t*)(L + GL_KH + i * GL_ST + dd * 2) = (bf16_t)cvtpk_s(kf * __expf(fminf(-Bv, 60.f)), 0.f);
            }
        }
        if (qr == 0) { ((LAS float*)(L + GL_EBL))[dd] = __expf(total); lsum_d += total; }
        __syncthreads();
        bf16x8 vfr[2][2];
#pragma unroll
        for (int kk = 0; kk < 2; ++kk)
#pragma unroll
            for (int nt = 0; nt < 2; ++nt) {
                const LAS unsigned char* vp = L + GL_V + (32 * kk + 8 * g + q4) * GL_VST + (32 * w + 16 * nt + 4 * p4) * 2;
                const v4i16_t lo = vtr(vp), hi = vtr(vp + 4 * GL_VST);
                vfr[kk][nt] = __builtin_shufflevector(lo, hi, 0, 1, 2, 3, 4, 5, 6, 7);
            }
        if (MODE == 1) {
            {
                const int it = w >> 1;
#pragma unroll
                for (int jj = 0; jj < 2; ++jj) {
                    const int jt = 2 * (w & 1) + jj;
                    f32x4 a4 = (f32x4){0.f, 0.f, 0.f, 0.f};
#pragma unroll
                    for (int kk = 0; kk < 4; ++kk) {
                        const bf16x8 a = *(const LAS bf16x8*)(L + GL_QT + (16 * it + c) * GL_ST + (8 * g + 32 * kk) * 2);
                        const bf16x8 b = *(const LAS bf16x8*)(L + GL_KH + (16 * jt + c) * GL_ST + (8 * g + 32 * kk) * 2);
                        a4 = MFMA16(a, b, a4);
                    }
#pragma unroll
                    for (int j = 0; j < 4; ++j) { const int i = 16 * it + 4 * g + j, jc = 16 * jt + c;
                        *(LAS bf16_t*)(L + GL_AM + i * GL_AST + jc * 2) = (bf16_t)f2bf(jc <= i ? a4[j] : 0.f); }
                }
            }
            __syncthreads();
            f32x4 o[2][4];
#pragma unroll
            for (int mt = 0; mt < 2; ++mt)
#pragma unroll
                for (int it = 0; it < 4; ++it) o[mt][it] = (f32x4){0.f, 0.f, 0.f, 0.f};
#pragma unroll
            for (int kq = 0; kq < 4; ++kq) {
                bf16x8 qb[4];
#pragma unroll
                for (int it = 0; it < 4; ++it) {
                    const LAS unsigned char* qp = L + GL_QT + (16 * it + c) * GL_ST + (32 * kq + 4 * g) * 2;
                    const u32x2 lo = *(const LAS u32x2*)qp, hi = *(const LAS u32x2*)(qp + 32);
                    u32x4 t4; t4.x = lo.x; t4.y = lo.y; t4.z = hi.x; t4.w = hi.y; qb[it] = __builtin_bit_cast(bf16x8, t4);
                }
#pragma unroll
                for (int mt = 0; mt < 2; ++mt) {
                    u32x4 sp; const f32x4 s0 = S[2 * kq][mt], s1 = S[2 * kq + 1][mt];
                    sp.x = cvtpk_s(s0[0], s0[1]); sp.y = cvtpk_s(s0[2], s0[3]); sp.z = cvtpk_s(s1[0], s1[1]); sp.w = cvtpk_s(s1[2], s1[3]);
                    const bf16x8 sa = __builtin_bit_cast(bf16x8, sp);
#pragma unroll
                    for (int it = 0; it < 4; ++it) o[mt][it] = MFMA16(sa, qb[it], o[mt][it]);
                }
                __builtin_amdgcn_sched_barrier(0);
            }
#pragma unroll
            for (int kk = 0; kk < 2; ++kk) {
#pragma unroll
                for (int it = 0; it < 4; ++it) {
                    const bf16x8 ab = *(const LAS bf16x8*)(L + GL_AM + (16 * it + c) * GL_AST + (32 * kk + 8 * g) * 2);
#pragma unroll
                    for (int mt = 0; mt < 2; ++mt) o[mt][it] = MFMA16(vfr[kk][mt], ab, o[mt][it]);
                }
                __builtin_amdgcn_sched_barrier(0);
            }
            {
                LAS float* red = (LAS float*)(L + GL_RED);
                u32x2 bwv[2][2];
#pragma unroll
                for (int it = 0; it < 2; ++it)
#pragma unroll
                    for (int mt = 0; mt < 2; ++mt) bwv[it][mt] = *(const u32x2*)(BB + (size_t)(t0 + 16 * it + c) * 3072 + 2048 + hh * 256 + 32 * w + 16 * mt + 4 * g);
                const f32x4 gv0 = *(const f32x4*)(gn + 32 * w + 4 * g), gv1 = *(const f32x4*)(gn + 32 * w + 16 + 4 * g);
#pragma unroll
                for (int it = 0; it < 4; ++it) {
                    float ss = 0.f;
#pragma unroll
                    for (int mt = 0; mt < 2; ++mt) ss += (o[mt][it][0] * o[mt][it][0] + o[mt][it][1] * o[mt][it][1]) + (o[mt][it][2] * o[mt][it][2] + o[mt][it][3] * o[mt][it][3]);
                    ss += __shfl_xor(ss, 16); ss += __shfl_xor(ss, 32);
                    if (g == 0) red[w * 64 + 16 * it + c] = ss;
                }
                __syncthreads();
#pragma unroll
                for (int ih = 0; ih < 2; ++ih) {
                    if (ih == 1) {
#pragma unroll
                        for (int it = 0; it < 2; ++it)
#pragma unroll
                            for (int mt = 0; mt < 2; ++mt) bwv[it][mt] = *(const u32x2*)(BB + (size_t)(t0 + 16 * (2 + it) + c) * 3072 + 2048 + hh * 256 + 32 * w + 16 * mt + 4 * g);
                    }
#pragma unroll
                    for (int i2 = 0; i2 < 2; ++i2) {
                        const int it = 2 * ih + i2;
                        float tot = 0.f;
#pragma unroll
                        for (int ww = 0; ww < 8; ++ww) tot += red[ww * 64 + 16 * it + c];
                        const float rstd = 1.0f / sqrtf(tot * (1.0f / 256.0f) + RMS_EPS);
                        const size_t t = (size_t)(t0 + 16 * it + c);
#pragma unroll
                        for (int mt = 0; mt < 2; ++mt) {
                            const int dv0 = 32 * w + 16 * mt + 4 * g;
                            const f32x4 gv = mt ? gv1 : gv0;
                            const u32x2 bw = bwv[i2][mt];
                            u32x2 ow;
                            ow.x = pk2(o[mt][it][0] * rstd * gv.x * pg8::silu_(bflo(bw.x)), o[mt][it][1] * rstd * gv.y * pg8::silu_(bfhi(bw.x)));
                            ow.y = pk2(o[mt][it][2] * rstd * gv.z * pg8::silu_(bflo(bw.y)), o[mt][it][3] * rstd * gv.w * pg8::silu_(bfhi(bw.y)));
                            *(u32x2*)(Hout + t * 2048 + 1024 + hh * 256 + dv0) = ow;
                        }
                    }
                }
            }
        }
#pragma unroll
        for (int mt = 0; mt < 8; ++mt) {
            const f32x4 sc = *(const LAS f32x4*)(L + GL_EBL + (16 * mt + 4 * g) * 4);
            bf16x8 ka[2];
#pragma unroll
            for (int kk = 0; kk < 2; ++kk) {
                const LAS unsigned char* kp = L + GL_KE + (32 * kk + 8 * g + q4) * GL_KST + (16 * mt + 4 * p4) * 2;
                const v4i16_t lo = vtr(kp), hi = vtr(kp + 4 * GL_KST);
                ka[kk] = __builtin_shufflevector(lo, hi, 0, 1, 2, 3, 4, 5, 6, 7);
            }
#pragma unroll
            for (int nt = 0; nt < 2; ++nt) {
                f32x4 sv = S[mt][nt] * sc;
#pragma unroll
                for (int kk = 0; kk < 2; ++kk) sv = MFMA16(ka[kk], vfr[kk][nt], sv);
                S[mt][nt] = sv;
            }
            __builtin_amdgcn_sched_barrier(0);
        }
    }
    if (MODE == 0) {
#pragma unroll
        for (int mt = 0; mt < 8; ++mt)
#pragma unroll
            for (int nt = 0; nt < 2; ++nt)
                { u32x2 pw; pw.x = cvtpk_s(S[mt][nt][0], S[mt][nt][1]); pw.y = cvtpk_s(S[mt][nt][2], S[mt][nt][3]); *(u32x2*)(sbase + (unsigned)((((mt * 2 + nt) * 8 + w) * 64 + (16 * g + c)) * 4)) = pw; }
        if (qr == 0) DG[(hh * 64 + grp) * 128 + dd] = __expf(lsum_d);
    }
    __syncthreads();
}

__constant__ float c_rope_inv[16] = {1.0f, 0.44036660267178046f, 0.19392274474868576f, 0.08539710028576561f, 0.03760603093086393f, 0.016560440080994446f, 0.007292664737217109f, 0.003211445994752591f,
                                     0.001414213562373095f, 0.000622772421914596f, 0.0002742481756762073f, 0.00012076973741146504f, 5.318295896944988e-05f, 2.341999896140934e-05f, 1.031338537721246e-05f, 4.5416704806078695e-06f};

__global__ void __launch_bounds__(NWAVES * 64, 2) fwd_megakernel(Args args) {
    extern __shared__ __attribute__((aligned(16))) unsigned char lds_raw[];
    cg::grid_group grid = cg::this_grid();
    Frame F;
    F.lds = (LAS unsigned char*)lds_raw;
    F.tid = threadIdx.x; F.lane = F.tid & 63; F.wave = __builtin_amdgcn_readfirstlane(F.tid >> 6);
    F.G = gridDim.x; F.gw = blockIdx.x * NWAVES + F.wave; F.NGW = F.G * NWAVES;
    unsigned char* ws = args.ws;
    volatile LAS unsigned* bar_st = (volatile LAS unsigned*)(F.lds + LDS_BYTES - 16);
    if (F.tid < 2) bar_st[F.tid] = 0u;
    __syncthreads();
    const XcdBarrier xbar = xcd_barrier_post((unsigned*)(ws + WS_BAR), bar_st);
    const float* x = args.in[0]; const int* positions = (const int*)args.in[1];
    float* out = args.out;
    bf16_t* Wgu = (bf16_t*)(ws + WS_WGU); bf16_t* Wd = (bf16_t*)(ws + WS_WD); bf16_t* Win = (bf16_t*)(ws + WS_WIN);
    bf16_t* WupA = (bf16_t*)(ws + WS_WUPA);
    bf16_t* Wout = (bf16_t*)(ws + WS_WOUT);
    bf16_t* H = (bf16_t*)(ws + WS_H); bf16_t* ACT = (bf16_t*)(ws + WS_ACT);
    bf16_t* QKVA = (bf16_t*)(ws + WS_QKVA); bf16_t* BB = (bf16_t*)(ws + WS_BB); unsigned char* GATES = (unsigned char*)(ws + WS_GATES);
    float* SS1 = (float*)(ws + WS_SS1);
    bf16_t* X1B = (bf16_t*)args.out;
    bf16_t* X2B = (bf16_t*)(ws + WS_X2B);
    float* BZ = (float*)(ws + WS_BZ);
    bf16_t* Y = (bf16_t*)(ws + WS_Y);

    {
        conv_matrix(F, args.in[3], FF, D, FF, 1, Wgu, 0, 0, args.in[2]);
        conv_matrix(F, args.in[4], FF, D, FF, 2, Wgu, 0, 0, args.in[2]);
        conv_matrix(F, args.in[5], D, FF, D, 0, Wd, 0);
        conv_matrix(F, args.in[7], 10256, D, NPROJ, 3, Win, 0);
        conv_matrix(F, args.in[13], D, AW, D, 0, WupA, 0, D);
        conv_matrix(F, args.in[14], D, AW, D, 0, WupA + 1024, 1024, D);
        conv_matrix(F, args.in[15], D, D, D, 0, Wout, 0);
        raw_rows_pipelined(F, x, H, SS1);
    }
    grid.sync();
    {
        pg8::Gemm g{H, Wgu, M, 2 * FF, D, D, D}; pg8::StaticOrder S; S.init(M, 2 * FF, F.G, (int)blockIdx.x);
        pg8::EpiSwiGLU E{ACT, FF, SS1};
        pg8::gemm_phase<pg8::EpiSwiGLU, true>(F.lds, g, S, E);
    }
    xcd_barrier(xbar);
    {
        pg8::Gemm g{ACT, Wd, M, D, FF, FF, FF}; pg8::StaticOrder S; S.init(M, D, F.G, (int)blockIdx.x, 4);
        pg8::EpiResidX<false, false> E{H, X1B, 0.5f};
        pg8::gemm_phase<pg8::EpiResidX<false, false>, true>(F.lds, g, S, E);
    }
    xcd_barrier(xbar);
    {
        LAS float* wz = (LAS float*)F.lds;
        const float* w_in = args.in[7];
        for (int e = F.tid; e < D * 16; e += NWAVES * 64) { const int k = e >> 4, j = e & 15; wz[j * D + k] = w_in[(size_t)k * 10256 + 6144 + j]; }
        __syncthreads();
        f32x4 gv[8], h0[8], h1[8]; load_gain(args.in[6], F.lane, gv);
        for (int m = F.gw; m < M; m += 2 * F.NGW) {
            const int m1 = m + F.NGW; const bool two = m1 < M;
            row_load(X1B + (size_t)m * D, F.lane, h0);
            if (two) row_load(X1B + (size_t)m1 * D, F.lane, h1);
            row_finish(h0, gv, H + (size_t)m * D, F.lane);
            if (two) row_finish(h1, gv, H + (size_t)m1 * D, F.lane);
            float mine0 = 0.f, mine1 = 0.f;
#pragma unroll 1
            for (int j = 0; j < 16; ++j) {
                float a0 = 0.f, a1 = 0.f;
#pragma unroll
                for (int i = 0; i < 8; ++i) { const f32x4 w = *(const LAS f32x4*)(wz + j * D + 256 * i + 4 * F.lane);
                    a0 += (h0[i].x * w.x + h0[i].y * w.y) + (h0[i].z * w.z + h0[i].w * w.w);
                    a1 += (h1[i].x * w.x + h1[i].y * w.y) + (h1[i].z * w.z + h1[i].w * w.w); }
                a0 = wave_sum(a0); a1 = wave_sum(a1);
                if (F.lane == j) { mine0 = a0; mine1 = a1; }
            }
            if (F.lane < 16) { BZ[(size_t)m * 16 + F.lane] = mine0; if (two) BZ[(size_t)m1 * 16 + F.lane] = mine1; }
        }
        __syncthreads();
    }
    xcd_barrier(xbar);
    {
        pg8::Gemm g{H, Win, M, NPROJ, D, D, D}; pg8::StaticOrder S; S.init(M, NPROJ, F.G, (int)blockIdx.x);
        pg8::EpiProj E{QKVA, BB, GATES};
        pg8::gemm_phase<pg8::EpiProj, true>(F.lds, g, S, E);
    }
    xcd_barrier(xbar);
    {
        const float* gq = args.in[8]; const float* gk = args.in[9]; const float* w2 = args.in[10]; const float* gb = args.in[11];
        const int lane = F.lane;
        for (int t = F.gw; t < M; t += F.NGW) {
            const float pos = (float)positions[t];
            unsigned* prow = (unsigned*)(QKVA + (size_t)t * 3072) + lane;
            unsigned wv[16];
#pragma unroll
            for (int v = 0; v < 16; ++v) wv[v] = prow[v * 64];
            float s0 = 0.f, c0 = 1.f, s1 = 0.f, c1 = 1.f;
            if (lane < 16) {
                const int i0 = (2 * lane) & 15;
                const float a0 = pos * c_rope_inv[i0], a1 = pos * c_rope_inv[i0 + 1];
                const double rv0 = (double)a0 * 0.15915494309189535, rv1 = (double)a1 * 0.15915494309189535;
                const float f0 = (float)(rv0 - rint(rv0)), f1 = (float)(rv1 - rint(rv1));
                s0 = __builtin_amdgcn_sinf(f0); c0 = __builtin_amdgcn_cosf(f0); s1 = __builtin_amdgcn_sinf(f1); c1 = __builtin_amdgcn_cosf(f1);
                if (lane < 8) { s0 = -s0; s1 = -s1; }
            }
            const float gq0 = gq[2 * lane], gq1 = gq[2 * lane + 1], gk0 = gk[2 * lane], gk1 = gk[2 * lane + 1];
#pragma unroll
            for (int v = 0; v < 16; ++v) {
                const float x0 = bflo(wv[v]), x1 = bfhi(wv[v]);
                const float ss = wave_sum(x0 * x0 + x1 * x1);
                const float r = 1.0f / sqrtf(ss * (1.0f / 128.0f) + RMS_EPS);
                float y0 = x0 * r * (v < 8 ? gq0 : gk0), y1 = x1 * r * (v < 8 ? gq1 : gk1);
                const float p0 = __shfl_xor(y0, 8), p1 = __shfl_xor(y1, 8);
                if (lane < 16) { y0 = y0 * c0 + p0 * s0; y1 = y1 * c1 + p1 * s1; }
                prow[v * 64] = pk2(y0, y1);
            }
        }
    }
    xcd_barrier(xbar);
    {
        bf16_t* OACC = (bf16_t*)(ws + WS_ORAW); float* LACC = (float*)ws;
        bf16_t* SLOC = (bf16_t*)(ws + WS_SLOC); float* DG = (float*)(ws + WS_DG);
        const float* gq = args.in[8]; const float* gk = args.in[9];
        const float mq = wave_max(fmaxf(fabsf(gq[2 * F.lane]), fabsf(gq[2 * F.lane + 1]))), mk = wave_max(fmaxf(fabsf(gk[2 * F.lane]), fabsf(gk[2 * F.lane + 1])));
        const float nb2 = -11.313708499f * mq * mk * 1.44269504089f;
        for (int it = blockIdx.x; it < 256; it += F.G) gla_item<0>(F, it >> 6, it & 63, BB, BZ, args.in[10], args.in[11], args.in[12], SLOC, DG, H);
        attn_pass<0>(F, QKVA, OACC, LACC, H, nb2);
        xcd_barrier(xbar);
        for (int e = blockIdx.x * 512 + F.tid; e < 4 * 128 * 256 / 2; e += F.G * 512) {
            const int hh = e >> 14, rem = (e & 16383) * 2, dk = 16 * (rem >> 12) + 4 * ((rem >> 6) & 3) + (rem & 3);
            float run0 = 0.f, run1 = 0.f;
#pragma unroll 1
            for (int g0 = 0; g0 < 64; g0 += 16) {
                unsigned tv[16]; f32x2 dv_[16];
#pragma unroll
                for (int u = 0; u < 16; ++u) { tv[u] = *(const unsigned*)(SLOC + (size_t)(hh * 64 + g0 + u) * 32768 + rem); dv_[u] = *(const f32x2*)(DG + (hh * 64 + g0 + u) * 128 + dk); }
#pragma unroll
                for (int u = 0; u < 16; ++u) { *(unsigned*)(SLOC + (size_t)(hh * 64 + g0 + u) * 32768 + rem) = cvtpk_s(run0, run1); run0 = dv_[u].x * run0 + bflo(tv[u]); run1 = dv_[u].y * run1 + bfhi(tv[u]); }
            }
        }
        attn_pass<1>(F, QKVA, OACC, LACC, H, nb2);
        xcd_barrier(xbar);
        for (int it = blockIdx.x; it < 256; it += F.G) gla_item<1>(F, it >> 6, it & 63, BB, BZ, args.in[10], args.in[11], args.in[12], SLOC, DG, H);
        attn_pass<2>(F, QKVA, OACC, LACC, H, nb2);
    }
    xcd_barrier(xbar);
    {
        pg8::StaticOrder S; S.init(M, D, F.G, (int)blockIdx.x, 4);
        pg8::Gemm g{H, WupA, M, D, D, D, D}; pg8::EpiGateY E{GATES, Y}; pg8::GateMid HK{GATES};
        pg8::gemm_phase<pg8::EpiGateY, true, pg8::GateMid>(F.lds, g, S, E, HK);
    }
    xcd_barrier(xbar);
    {
        pg8::Gemm g{Y, Wout, M, D, D, D, D}; pg8::StaticOrder S; S.init(M, D, F.G, (int)blockIdx.x, 4);
        pg8::EpiResidX<false, false> E{X1B, X2B, 1.0f};
        pg8::gemm_phase<pg8::EpiResidX<false, false>, true>(F.lds, g, S, E);
    }
    xcd_barrier(xbar);
    {
        conv_matrix(F, args.in[17], FF, D, FF, 1, Wgu, 0);
        conv_matrix(F, args.in[18], FF, D, FF, 2, Wgu, 0);
        conv_matrix(F, args.in[19], D, FF, D, 0, Wd, 0);
        rms_rows_pipelined(F, X2B, args.in[16], H);
    }
    xcd_barrier(xbar);
    {
        pg8::Gemm g{H, Wgu, M, 2 * FF, D, D, D}; pg8::StaticOrder S; S.init(M, 2 * FF, F.G, (int)blockIdx.x);
        pg8::EpiSwiGLU E{ACT, FF, nullptr};
        pg8::gemm_phase<pg8::EpiSwiGLU, true>(F.lds, g, S, E);
    }
    xcd_barrier(xbar);
    {
        pg8::Gemm g{ACT, Wd, M, D, FF, FF, FF}; pg8::StaticOrder S; S.init(M, D, F.G, (int)blockIdx.x, 4);
        pg8::EpiResidX<false, true> E{X2B, out, 0.5f};
        pg8::gemm_phase<pg8::EpiResidX<false, true>, true>(F.lds, g, S, E);
    }
}

extern "C" void kernel_launch(void* const* d_in, const int* in_sizes, int n_in, void* d_out, int out_size, void* d_ws, size_t ws_size, hipStream_t stream) {
    static int grid = 0;
    if (grid == 0) {
        if (n_in != 20 || in_sizes[0] != M * D || out_size != M * D || ws_size < WS_END) { fprintf(stderr, "kernel_launch: unexpected shapes / workspace (n_in %d, ws %zu)\n", n_in, ws_size); grid = -1; return; }
        int dev = 0, cus = 0, per_cu = 0;
        (void)hipGetDevice(&dev); (void)hipDeviceGetAttribute(&cus, hipDeviceAttributeMultiprocessorCount, dev);
        if (hipFuncSetAttribute((const void*)fwd_megakernel, hipFuncAttributeMaxDynamicSharedMemorySize, LDS_BYTES) != hipSuccess) { fprintf(stderr, "kernel_launch: hipFuncSetAttribute failed\n"); grid = -1; return; }
        if (hipOccupancyMaxActiveBlocksPerMultiprocessor(&per_cu, (const void*)fwd_megakernel, NWAVES * 64, LDS_BYTES) != hipSuccess || per_cu < 1) { fprintf(stderr, "kernel_launch: occupancy query says %d\n", per_cu); (void)hipGetLastError(); }
        grid = cus;
    }
    if (grid < 0) return;
    if (hipMemsetAsync((char*)d_ws + WS_BAR, 0, 16384, stream) != hipSuccess) { fprintf(stderr, "kernel_launch: memset failed\n"); return; }
    Args a{};
    for (int i = 0; i < 20; ++i) a.in[i] = (const float*)d_in[i];
    a.out = (float*)d_out; a.ws = (unsigned char*)d_ws;
    void* kargs[] = {&a};
    hipError_t e = hipLaunchCooperativeKernel((const void*)fwd_megakernel, dim3(grid), dim3(NWAVES * 64), kargs, LDS_BYTES, stream);
    if (e != hipSuccess) fprintf(stderr, "cooperative launch failed: %s (grid %d)\n", hipGetErrorString(e), grid);
}
```

```cpp
#include <hip/hip_runtime.h>
#include <hip/hip_cooperative_groups.h>
#include <cstdio>
#include <cstdint>
namespace cg = cooperative_groups;

#define LAS __attribute__((address_space(3)))
typedef unsigned short bf16_t;
typedef short bf16x8 __attribute__((ext_vector_type(8)));
typedef float f32x4 __attribute__((ext_vector_type(4)));
typedef float f32x2 __attribute__((ext_vector_type(2)));
typedef unsigned u32x4 __attribute__((ext_vector_type(4)));
typedef unsigned u32x2 __attribute__((ext_vector_type(2)));

constexpr int M = 16384, D = 2048, FF = 5632;
constexpr int NPROJ = 10240;
constexpr int AW = 1024;
constexpr float RMS_EPS = 1e-6f;
constexpr int NWAVES = 8;

constexpr size_t MiB = 1u << 20;
constexpr size_t WS_BAR = 768 * 1024;
constexpr size_t WS_BZ = 1 * MiB;
constexpr size_t WS_WGU = 2 * MiB;
constexpr size_t WS_WD = 46 * MiB;
constexpr size_t WS_ORAW = 2 * MiB;
constexpr size_t WS_Y = 2 * MiB;
constexpr size_t WS_WIN = 68 * MiB;
constexpr size_t WS_SLOC = 68 * MiB;
constexpr size_t WS_DG = 100 * MiB;
constexpr size_t WS_WUPA = 108 * MiB, WS_WUPB = 112 * MiB;
constexpr size_t WS_WOUT = 116 * MiB;
constexpr size_t WS_H = 124 * MiB;
constexpr size_t WS_QKVA = 188 * MiB;
constexpr size_t WS_BB = 284 * MiB;
constexpr size_t WS_GATES = 380 * MiB;
constexpr size_t WS_ACT = 188 * MiB;
constexpr size_t WS_T = 188 * MiB;
constexpr size_t WS_X2B = 380 * MiB;
constexpr size_t WS_END = 508 * MiB;

constexpr int LDS_BYTES = 147456;

__device__ __forceinline__ unsigned f2bf(float f) { unsigned u = __builtin_bit_cast(unsigned, f); return (u + 0x7fffu + ((u >> 16) & 1u)) >> 16; }
__device__ __forceinline__ unsigned pk2(float lo, float hi) { return f2bf(lo) | (f2bf(hi) << 16); }
__device__ __forceinline__ float bf2f(unsigned short b) { return __builtin_bit_cast(float, (unsigned)b << 16); }
__device__ __forceinline__ float bflo(unsigned w) { return __builtin_bit_cast(float, w << 16); }
__device__ __forceinline__ float bfhi(unsigned w) { return __builtin_bit_cast(float, w & 0xffff0000u); }
__device__ __forceinline__ float wave_sum(float v) {
#pragma unroll
    for (int o = 1; o < 64; o <<= 1) v += __shfl_xor(v, o);
    return v;
}
__device__ __forceinline__ float wave_max(float v) {
#pragma unroll
    for (int o = 1; o < 64; o <<= 1) v = fmaxf(v, __shfl_xor(v, o));
    return v;
}
__device__ __forceinline__ float sigmoidf_(float x) { return __builtin_amdgcn_rcpf(1.0f + __builtin_amdgcn_exp2f(-1.44269504089f * x)); }

namespace pg8 {
constexpr int BM = 256, BK = 64, HALF = 128, HTB = HALF * BK * 2, STAGE_BYTES = 8 * HTB, NXCD = 8;
__host__ __device__ __forceinline__ int lds_byte(int r, int c) { const int st = (r >> 4) * 2 + (c >> 5), rr = r & 15, cc = c & 31, ob = rr * 64 + cc * 2; return st * 1024 + (ob ^ (((ob >> 9) & 1) << 5)); }
__host__ __device__ __forceinline__ void stage_rc(int b, int& R, int& C) { const int st = b / 1024, sb = b % 1024, swz = sb ^ (((sb >> 9) & 1) << 5); R = (st >> 1) * 16 + swz / 64; C = (st & 1) * 32 + (swz % 64) / 2; }
__host__ __device__ __forceinline__ int perm32(int rho) { const int n = rho >> 4, i = rho & 15; return 8 * (i >> 2) + 4 * n + (i & 3); }

struct Unit { int pm, pn; };
struct Gemm { const bf16_t* A; const bf16_t* Bt; int M, N, K, lda, ldb; };

struct StaticOrder {
    int nM, nN, nwg, G, c, WGM, cperm = 0;
    __host__ __device__ void init(int M_, int N_, int G_, int c_, int wgm = 8) { nM = M_ / BM; nN = N_ / BM; nwg = nM * nN; G = G_; c = c_; WGM = wgm; }
    __host__ __device__ bool next(int i, Unit& u) const {
        const long L = (long)i * G + c; if (L >= nwg) return false;
        int wgid = (int)L; { const int q = nwg / NXCD, r = nwg % NXCD, xcd = wgid % NXCD, off = wgid / NXCD; wgid = (xcd < r ? xcd * (q + 1) : r * (q + 1) + (xcd - r) * q) + off; }
        const int nig = WGM * nN, gid = wgid / nig, fm = gid * WGM, gsz = (nM - fm) < WGM ? (nM - fm) : WGM;
        u.pm = fm + ((wgid % nig) % gsz); u.pn = (wgid % nig) / gsz; if (cperm) u.pn = (u.pn % 5) * 8 + u.pn / 5; return true;
    }
};

__device__ __forceinline__ unsigned cvt_pk_bf16(float lo, float hi) { unsigned r; asm volatile("v_cvt_pk_bf16_f32 %0, %1, %2" : "=v"(r) : "v"(lo), "v"(hi)); return r; }

__device__ __forceinline__ float silu_(float g) { return g * __builtin_amdgcn_rcpf(1.0f + __builtin_amdgcn_exp2f(-1.44269504089f * g)); }
__device__ __forceinline__ f32x2 silu_mul_pk(f32x2 g, f32x2 u) {
    const f32x2 t = g * (-1.44269504089f);
    f32x2 e; e.x = __builtin_amdgcn_exp2f(t.x); e.y = __builtin_amdgcn_exp2f(t.y);
    const f32x2 dd = e + 1.0f;
    f32x2 r; r.x = __builtin_amdgcn_rcpf(dd.x); r.y = __builtin_amdgcn_rcpf(dd.y);
    return (g * r) * u;
}
__device__ __forceinline__ f32x2 sigmoid_pk(f32x2 g) {
    const f32x2 t = g * (-1.44269504089f);
    f32x2 e; e.x = __builtin_amdgcn_exp2f(t.x); e.y = __builtin_amdgcn_exp2f(t.y);
    const f32x2 dd = e + 1.0f;
    f32x2 r; r.x = __builtin_amdgcn_rcpf(dd.x); r.y = __builtin_amdgcn_rcpf(dd.y);
    return r;
}

struct EpiSwiGLU {
    static constexpr bool PERM = true;
    bf16_t* O; int ldc;
    __device__ __forceinline__ void operator()(const f32x4 (&acc)[2][2][4][2], const Unit& u, int wr, int wc, int fr, int fq) const {
        const int row0 = u.pm * BM + wr * 64 + fr; const int col0 = u.pn * HALF + wc * 32 + 8 * fq;
#pragma unroll
        for (int ai = 0; ai < 2; ++ai)
#pragma unroll
            for (int m = 0; m < 4; ++m) {
                bf16_t* rowp = O + (size_t)(row0 + ai * HALF + m * 16) * ldc + col0;
                const f32x4 g0 = acc[ai][0][m][0], g1 = acc[ai][0][m][1], u0 = acc[ai][1][m][0], u1 = acc[ai][1][m][1];
                const f32x2 a = silu_mul_pk((f32x2){g0[0], g0[1]}, (f32x2){u0[0], u0[1]}), b = silu_mul_pk((f32x2){g0[2], g0[3]}, (f32x2){u0[2], u0[3]});
                const f32x2 c = silu_mul_pk((f32x2){g1[0], g1[1]}, (f32x2){u1[0], u1[1]}), d = silu_mul_pk((f32x2){g1[2], g1[3]}, (f32x2){u1[2], u1[3]});
                u32x4 w; w.x = cvt_pk_bf16(a.x, a.y); w.y = cvt_pk_bf16(b.x, b.y); w.z = cvt_pk_bf16(c.x, c.y); w.w = cvt_pk_bf16(d.x, d.y);
                *(u32x4*)rowp = w;
            }
    }
};
struct EpiResid {
    static constexpr bool PERM = false;
    const float* base; float* out; int ldc; float scale;
    __device__ __forceinline__ void operator()(const f32x4 (&acc)[2][2][4][2], const Unit& u, int wr, int wc, int fr, int fq) const {
        const int col0 = u.pn * BM + wc * 32 + 4 * fq;
#pragma unroll
        for (int ai = 0; ai < 2; ++ai) {
            f32x4 pre[4][2][2];
#pragma unroll
            for (int m = 0; m < 4; ++m) {
                const size_t off = (size_t)(u.pm * BM + ai * HALF + wr * 64 + m * 16 + fr) * ldc + col0;
#pragma unroll
                for (int bj = 0; bj < 2; ++bj)
#pragma unroll
                    for (int n = 0; n < 2; ++n) pre[m][bj][n] = *(const f32x4*)(base + off + bj * HALF + n * 16);
            }
#pragma unroll
            for (int m = 0; m < 4; ++m) {
                const size_t off = (size_t)(u.pm * BM + ai * HALF + wr * 64 + m * 16 + fr) * ldc + col0;
#pragma unroll
                for (int bj = 0; bj < 2; ++bj)
#pragma unroll
                    for (int n = 0; n < 2; ++n) *(f32x4*)(out + off + bj * HALF + n * 16) = pre[m][bj][n] + acc[ai][bj][m][n] * scale;
            }
        }
    }
};
template <bool IN_F32, bool OUT_F32> struct EpiResidX {
    static constexpr bool PERM = true;
    const void* base; void* out; float scale;
    __device__ __forceinline__ void operator()(const f32x4 (&acc)[2][2][4][2], const Unit& u, int wr, int wc, int fr, int fq) const {
        const int row0 = u.pm * BM + wr * 64 + fr; const int col0 = u.pn * BM + wc * 32 + 8 * fq;
#pragma unroll
        for (int ai = 0; ai < 2; ++ai) {
            f32x4 p0[4][2], p1[4][2];
#pragma unroll
            for (int m = 0; m < 4; ++m)
#pragma unroll
                for (int bj = 0; bj < 2; ++bj) {
                    const size_t e = (size_t)(row0 + ai * HALF + m * 16) * 2048 + col0 + bj * HALF;
                    if (IN_F32) { p0[m][bj] = *(const f32x4*)((const float*)base + e); p1[m][bj] = *(const f32x4*)((const float*)base + e + 4); }
                    else { const u32x4 w = *(const u32x4*)((const bf16_t*)base + e); p0[m][bj] = (f32x4){bflo(w.x), bfhi(w.x), bflo(w.y), bfhi(w.y)}; p1[m][bj] = (f32x4){bflo(w.z), bfhi(w.z), bflo(w.w), bfhi(w.w)}; }
                }
#pragma unroll
            for (int m = 0; m < 4; ++m)
#pragma unroll
                for (int bj = 0; bj < 2; ++bj) {
                    const size_t e = (size_t)(row0 + ai * HALF + m * 16) * 2048 + col0 + bj * HALF;
                    const f32x4 v0 = p0[m][bj] + acc[ai][bj][m][0] * scale, v1 = p1[m][bj] + acc[ai][bj][m][1] * scale;
                    if (OUT_F32) { *(f32x4*)((float*)out + e) = v0; *(f32x4*)((float*)out + e + 4) = v1; }
                    else { u32x4 w; w.x = cvt_pk_bf16(v0[0], v0[1]); w.y = cvt_pk_bf16(v0[2], v0[3]); w.z = cvt_pk_bf16(v1[0], v1[1]); w.w = cvt_pk_bf16(v1[2], v1[3]); *(u32x4*)((bf16_t*)out + e) = w; }
                }
        }
    }
};
__device__ __forceinline__ unsigned qbyte(float sgm) { const float t = fminf(sgm * 256.0f, 255.0f); return (unsigned)t; }
__device__ __forceinline__ float ubyte(unsigned w, int k) { return (float)((w >> (8 * k)) & 0xffu); }
struct EpiProj {
    static constexpr bool PERM = true;
    bf16_t* qkva; bf16_t* bb; unsigned char* gates;
    __device__ __forceinline__ void operator()(const f32x4 (&acc)[2][2][4][2], const Unit& u, int wr, int wc, int fr, int fq) const {
        bf16_t* base = qkva; int ldc = 3072, colt; bool sg = false;
        if (u.pn < 12) { colt = u.pn * BM; } else if (u.pn < 24) { base = bb; colt = (u.pn - 12) * BM; } else { colt = (u.pn - 24) * BM; sg = true; }
        const int row0 = u.pm * BM + wr * 64 + fr; const int col0 = colt + wc * 32 + 8 * fq;
#pragma unroll
        for (int ai = 0; ai < 2; ++ai)
#pragma unroll
            for (int m = 0; m < 4; ++m) {
                bf16_t* rowp = base + (size_t)(row0 + ai * HALF + m * 16) * ldc + col0;
#pragma unroll
                for (int bj = 0; bj < 2; ++bj) {
                    f32x4 v0 = acc[ai][bj][m][0], v1 = acc[ai][bj][m][1];
                    if (sg) {
                        const f32x2 a = sigmoid_pk((f32x2){v0[0], v0[1]}), b = sigmoid_pk((f32x2){v0[2], v0[3]}), c = sigmoid_pk((f32x2){v1[0], v1[1]}), d = sigmoid_pk((f32x2){v1[2], v1[3]});
                        u32x2 qw;
                        qw.x = qbyte(a.x) | (qbyte(a.y) << 8) | (qbyte(b.x) << 16) | (qbyte(b.y) << 24);
                        qw.y = qbyte(c.x) | (qbyte(c.y) << 8) | (qbyte(d.x) << 16) | (qbyte(d.y) << 24);
                        *(u32x2*)(gates + (size_t)(row0 + ai * HALF + m * 16) * 4096 + col0 + bj * HALF) = qw;
                        continue;
                    }
                    u32x4 w; w.x = cvt_pk_bf16(v0[0], v0[1]); w.y = cvt_pk_bf16(v0[2], v0[3]); w.z = cvt_pk_bf16(v1[0], v1[1]); w.w = cvt_pk_bf16(v1[2], v1[3]);
                    *(u32x4*)(rowp + bj * HALF) = w;
                }
            }
    }
};
struct NoHook { static constexpr int AT = -1; __device__ __forceinline__ void operator()(f32x4 (&)[2][2][4][2], const Unit&, int, int, int, int) const {} };
struct GateMid {
    static constexpr int AT = 16;
    const unsigned char* G;
    __device__ __forceinline__ void operator()(f32x4 (&acc)[2][2][4][2], const Unit& u, int wr, int wc, int fr, int fq) const {
        asm volatile("" : "+v"(fr), "+v"(fq));
        const int row0 = u.pm * BM + wr * 64 + fr; const int col0 = u.pn * BM + wc * 32 + 8 * fq;
        const unsigned char* gp = G + (size_t)row0 * 4096 + col0;
#pragma unroll
        for (int ai = 0; ai < 2; ++ai) {
            u32x2 ga[4][2], gb[4][2];
#pragma unroll
            for (int m = 0; m < 4; ++m)
#pragma unroll
                for (int bj = 0; bj < 2; ++bj) { const unsigned r = (unsigned)(ai * HALF + m * 16) * 4096u; ga[m][bj] = *(const u32x2*)(gp + r + bj * HALF); gb[m][bj] = *(const u32x2*)(gp + r + 2048 + bj * HALF); }
            asm volatile("" ::: "memory");
#pragma unroll
            for (int m = 0; m < 4; ++m)
#pragma unroll
                for (int bj = 0; bj < 2; ++bj) {
                    const u32x2 a = ga[m][bj], b = gb[m][bj];
                    f32x4 v0 = acc[ai][bj][m][0], v1 = acc[ai][bj][m][1];
#pragma unroll
                    for (int k = 0; k < 4; ++k) {
                        v0[k] *= (ubyte(a.x, k) + 0.5f) * __builtin_amdgcn_rcpf(ubyte(b.x, k) + 0.5f);
                        v1[k] *= (ubyte(a.y, k) + 0.5f) * __builtin_amdgcn_rcpf(ubyte(b.y, k) + 0.5f);
                    }
                    acc[ai][bj][m][0] = v0; acc[ai][bj][m][1] = v1;
                }
            asm volatile("" ::: "memory");
        }
    }
};
struct EpiGateY {
    static constexpr bool PERM = true;
    const unsigned char* G; bf16_t* Y;
    __device__ __forceinline__ void operator()(const f32x4 (&acc)[2][2][4][2], const Unit& u, int wr, int wc, int fr, int fq) const {
        const int row0 = u.pm * BM + wr * 64 + fr; const int col0 = u.pn * BM + wc * 32 + 8 * fq;
#pragma unroll
        for (int ai = 0; ai < 2; ++ai) {
            u32x2 gpre[4][2];
#pragma unroll
            for (int m = 0; m < 4; ++m)
#pragma unroll
                for (int bj = 0; bj < 2; ++bj) gpre[m][bj] = *(const u32x2*)(G + (size_t)(row0 + ai * HALF + m * 16) * 4096 + 2048 + col0 + bj * HALF);
#pragma unroll
            for (int m = 0; m < 4; ++m) {
                const size_t r = (size_t)(row0 + ai * HALF + m * 16);
#pragma unroll
                for (int bj = 0; bj < 2; ++bj) {
                    const u32x2 g = gpre[m][bj];
                    f32x4 v0 = acc[ai][bj][m][0], v1 = acc[ai][bj][m][1];
#pragma unroll
                    for (int k = 0; k < 4; ++k) { v0[k] *= (ubyte(g.x, k) + 0.5f) * (1.0f / 256.0f); v1[k] *= (ubyte(g.y, k) + 0.5f) * (1.0f / 256.0f); }
                    u32x4 w; w.x = cvt_pk_bf16(v0[0], v0[1]); w.y = cvt_pk_bf16(v0[2], v0[3]); w.z = cvt_pk_bf16(v1[0], v1[1]); w.w = cvt_pk_bf16(v1[2], v1[3]);
                    *(u32x4*)(Y + r * 2048 + col0 + bj * HALF) = w;
                }
            }
        }
    }
};

template <class Epi, bool ALIGN_EPI, class Hook = NoHook>
__device__ __forceinline__ void gemm_phase(LAS unsigned char* lds, const Gemm g, const StaticOrder& S, const Epi& E, const Hook& HK = Hook()) {
    int tid = threadIdx.x; asm volatile("" : "+v"(tid));
    const int wid = __builtin_amdgcn_readfirstlane(tid >> 6), lane = tid & 63, wr = wid >> 2, wc = wid & 3, fr = lane & 15, fq = lane >> 4;
    const int K = g.K, nt = K / BK;
    unsigned voffA[2], voffB[2];
#pragma unroll
    for (int i = 0; i < 2; ++i) { int R, C; stage_rc(tid * 16 + i * 8192, R, C); const int Rb = Epi::PERM ? ((R & ~31) + perm32(R & 31)) : R;
        voffA[i] = (unsigned)(R * g.lda + C) * 2u; voffB[i] = (unsigned)(Rb * g.ldb + C) * 2u; }
    const size_t kstep = (size_t)(BK * 2);
    const size_t hstepA = (size_t)HALF * g.lda * 2, hstepB = (size_t)HALF * g.ldb * 2;
    const size_t tstepA = 2 * hstepA, tstepB = 2 * hstepB;
    const unsigned ldsw = (unsigned)wid * 1024u;
    const int aoff = lds_byte(wr * 64 + fr, fq * 8), boff = lds_byte(wc * 32 + fr, fq * 8);
#define PG8_SA(b, h) (((b) * 2 + (h)) * HTB)
#define PG8_SB(b, h) ((4 + (b) * 2 + (h)) * HTB)
#define PG8_STAGE(bufoff, gbase, voff) do { _Pragma("unroll") for (int _i = 0; _i < 2; ++_i) \
        __builtin_amdgcn_global_load_lds((const unsigned*)((const char*)(gbase) + (voff)[_i]), (LAS unsigned*)(lds + (bufoff) + ldsw + _i * 8192), 16, 0, 0); } while (0)
#define PG8_LDA(dst, b, h) do { _Pragma("unroll") for (int m = 0; m < 4; ++m) _Pragma("unroll") for (int k = 0; k < 2; ++k) dst[m][k] = *(const LAS bf16x8*)(lds + PG8_SA(b, h) + aoff + m * 2048 + k * 1024); } while (0)
#define PG8_LDB(dst, b, h) do { _Pragma("unroll") for (int n = 0; n < 2; ++n) _Pragma("unroll") for (int k = 0; k < 2; ++k) dst[n][k] = *(const LAS bf16x8*)(lds + PG8_SB(b, h) + boff + n * 2048 + k * 1024); } while (0)
#define PG8_MMA(ai, bj, At, Bt) do { __builtin_amdgcn_s_setprio(1); _Pragma("unroll") for (int m = 0; m < 4; ++m) _Pragma("unroll") for (int n = 0; n < 2; ++n) _Pragma("unroll") for (int k = 0; k < 2; ++k) \
        acc[ai][bj][m][n] = __builtin_amdgcn_mfma_f32_16x16x32_bf16(Bt[n][k], At[m][k], acc[ai][bj][m][n], 0, 0, 0); __builtin_amdgcn_s_setprio(0); } while (0)
#define PG8_WAIT_V(n) asm volatile("s_waitcnt vmcnt(" #n ")" ::: "memory")
#define PG8_WAIT_L(n) asm volatile("s_waitcnt lgkmcnt(" #n ")" ::: "memory")
#define PG8_BAR __builtin_amdgcn_s_barrier()
#define PG8_SCHED __builtin_amdgcn_sched_barrier(0)
    Unit cur, nxt; int ui = 0;
    if (!S.next(0, cur)) return;
    f32x4 acc[2][2][4][2];
#pragma unroll
    for (int a = 0; a < 2; ++a)
#pragma unroll
        for (int b = 0; b < 2; ++b)
#pragma unroll
            for (int m = 0; m < 4; ++m)
#pragma unroll
                for (int n = 0; n < 2; ++n) acc[a][b][m][n] = (f32x4){0.f, 0.f, 0.f, 0.f};
    bf16x8 At[4][2], B0[2][2], B1[2][2];
    const char* cA = (const char*)g.A + (size_t)cur.pm * tstepA; const char* cB = (const char*)g.Bt + (size_t)cur.pn * tstepB;
    PG8_STAGE(PG8_SB(0, 0), cB, voffB); PG8_STAGE(PG8_SB(0, 1), cB + hstepB, voffB); PG8_STAGE(PG8_SA(0, 0), cA, voffA); PG8_STAGE(PG8_SA(0, 1), cA + hstepA, voffA);
    if (wr == 1) PG8_BAR;
    PG8_WAIT_V(2); PG8_BAR;
    PG8_STAGE(PG8_SB(1, 0), cB + kstep, voffB); PG8_STAGE(PG8_SA(1, 0), cA + kstep, voffA); PG8_STAGE(PG8_SB(1, 1), cB + hstepB + kstep, voffB);
    PG8_WAIT_V(6); PG8_BAR;
    for (;;) {
        const bool has_next = S.next(ui + 1, nxt);
        const char* nA = has_next ? (const char*)g.A + (size_t)nxt.pm * tstepA : cA; const char* nB = has_next ? (const char*)g.Bt + (size_t)nxt.pn * tstepB : cB;
        for (int t = 0; t < nt; t += 2) {
            if (Hook::AT > 0 && t == Hook::AT) HK(acc, cur, wr, wc, fr, fq);
            const bool last = (t == nt - 2);
            const char* a1 = cA + (size_t)(t + 1) * kstep;
            const char* a2 = last ? nA : cA + (size_t)(t + 2) * kstep; const char* b2 = last ? nB : cB + (size_t)(t + 2) * kstep;
            const char* a3 = a2 + kstep; const char* b3 = b2 + kstep;
            PG8_LDB(B0, 0, 0); PG8_LDB(B1, 0, 1); PG8_SCHED; PG8_LDA(At, 0, 0); PG8_STAGE(PG8_SA(1, 1), a1 + hstepA, voffA);
            PG8_WAIT_V(8); PG8_WAIT_L(0); PG8_BAR; PG8_MMA(0, 0, At, B0); PG8_MMA(0, 1, At, B1); PG8_BAR; PG8_SCHED;
            PG8_LDA(At, 0, 1); PG8_STAGE(PG8_SB(0, 0), b2, voffB); PG8_STAGE(PG8_SB(0, 1), b2 + hstepB, voffB); PG8_STAGE(PG8_SA(0, 0), a2, voffA);
            PG8_WAIT_V(8); PG8_WAIT_L(0); PG8_BAR; PG8_MMA(1, 0, At, B0); PG8_MMA(1, 1, At, B1); PG8_BAR; PG8_SCHED;
            PG8_LDB(B0, 1, 0); PG8_LDB(B1, 1, 1); PG8_SCHED; PG8_LDA(At, 1, 0); PG8_STAGE(PG8_SA(0, 1), a2 + hstepA, voffA);
            PG8_WAIT_V(8); PG8_WAIT_L(0); PG8_BAR; PG8_MMA(0, 0, At, B0); PG8_MMA(0, 1, At, B1); PG8_BAR; PG8_SCHED;
            PG8_LDA(At, 1, 1); PG8_STAGE(PG8_SB(1, 0), b3, voffB); PG8_STAGE(PG8_SB(1, 1), b3 + hstepB, voffB); PG8_STAGE(PG8_SA(1, 0), a3, voffA);
            PG8_WAIT_V(8); PG8_WAIT_L(0); PG8_BAR; PG8_MMA(1, 0, At, B0); PG8_MMA(1, 1, At, B1); PG8_BAR; PG8_SCHED;
        }
        if constexpr (ALIGN_EPI) { if (wr == 0) PG8_BAR; }
        E(acc, cur, wr, wc, fr, fq);
        if (!has_next) break;
#pragma unroll
        for (int a = 0; a < 2; ++a)
#pragma unroll
            for (int b = 0; b < 2; ++b)
#pragma unroll
                for (int m = 0; m < 4; ++m)
#pragma unroll
                    for (int n = 0; n < 2; ++n) acc[a][b][m][n] = (f32x4){0.f, 0.f, 0.f, 0.f};
        cur = nxt; cA = nA; cB = nB; ++ui;
        if constexpr (ALIGN_EPI) { if (wr == 1) PG8_BAR; }
    }
    PG8_WAIT_V(0);
    if constexpr (!ALIGN_EPI) { if (wr == 0) PG8_BAR; }
    PG8_BAR;
#undef PG8_SA
#undef PG8_SB
#undef PG8_STAGE
#undef PG8_LDA
#undef PG8_LDB
#undef PG8_MMA
#undef PG8_WAIT_V
#undef PG8_WAIT_L
#undef PG8_BAR
#undef PG8_SCHED
}
}


#define XB_TMO      128
#define XB_XCNT(j)  (256  + 64 * (j))
#define XB_XSUB(j)  (1280 + 64 * (j))
#define XB_XGEN(j)  (2304 + 64 * (j))
#define XB_TOP      3328
#define XB_TOPGEN   3392
#define XCD_BAR_WORDS 3456
#define XB_SPIN_CAP (1u << 20)
__device__ __forceinline__ unsigned xb_ld(unsigned* p)              { return __hip_atomic_load(p, __ATOMIC_RELAXED, __HIP_MEMORY_SCOPE_AGENT); }
__device__ __forceinline__ unsigned xb_add(unsigned* p, unsigned v) { return __hip_atomic_fetch_add(p, v, __ATOMIC_RELAXED, __HIP_MEMORY_SCOPE_AGENT); }
__device__ __forceinline__ unsigned xb_xcc_id() { return (unsigned)__builtin_amdgcn_s_getreg((3 << 11) | 20) & 0xFu; }
#define XB_SPIN(cond, bar) do { unsigned _sp = 0; while (cond) { __builtin_amdgcn_s_sleep(1); \
    if ((++_sp & 255u) == 0u) { if (xb_ld(&(bar)[XB_TMO])) break; if (_sp > XB_SPIN_CAP) { atomicAdd(&(bar)[XB_TMO], 1u); break; } } } } while (0)
struct XcdBarrier { unsigned* bar; unsigned x; volatile LAS unsigned* st; };
__device__ __forceinline__ XcdBarrier xcd_barrier_post(unsigned* bar, volatile LAS unsigned* st) {
    XcdBarrier b; b.bar = bar; b.x = xb_xcc_id(); b.st = st;
    if (threadIdx.x == 0) (void)xb_add(&bar[XB_XCNT(b.x)], 1u);
    return b;
}
__device__ __forceinline__ void xcd_barrier_complete(unsigned* bar, unsigned x, unsigned& nloc, unsigned& nx) {
    const unsigned G = gridDim.x * gridDim.y * gridDim.z;
    unsigned sum, cnt, mine, sp = 0u;
    for (;;) {
        sum = 0u; cnt = 0u; mine = 0u;
#pragma unroll
        for (unsigned j = 0; j < 16; ++j) { const unsigned c = xb_ld(&bar[XB_XCNT(j)]); sum += c; cnt += (c > 0u) ? 1u : 0u; mine = (j == x) ? c : mine; }
        if (sum == G) break;
        __builtin_amdgcn_s_sleep(1);
        if ((++sp & 255u) == 0u) { if (xb_ld(&bar[XB_TMO])) break; if (sp > XB_SPIN_CAP) { atomicAdd(&bar[XB_TMO], 1u); break; } }
    }
    nloc = mine > 0u ? mine : 1u; nx = cnt > 0u ? cnt : 1u;
}
__device__ __forceinline__ void xcd_barrier(const XcdBarrier& b) {
    asm volatile("s_waitcnt vmcnt(0)" ::: "memory");
    __syncthreads();
    if (threadIdx.x == 0) {
        unsigned* bar = b.bar;
        __builtin_amdgcn_s_waitcnt(0);
        unsigned nloc = b.st[0], nx = b.st[1];
        if (nloc == 0u) { xcd_barrier_complete(bar, b.x, nloc, nx); b.st[0] = nloc; b.st[1] = nx; }
        const unsigned old = xb_add(&bar[XB_XSUB(b.x)], 1u);
        const unsigned gen = old / nloc;
        if (old + 1u == (gen + 1u) * nloc) {
            __builtin_amdgcn_fence(__ATOMIC_RELEASE, "agent");
            asm volatile("s_waitcnt vmcnt(0)" ::: "memory");
            const unsigned og = xb_add(&bar[XB_TOP], 1u);
            const unsigned tg = og / nx;
            if (og + 1u == (tg + 1u) * nx) xb_add(&bar[XB_TOPGEN], 1u);
            else XB_SPIN(xb_ld(&bar[XB_TOPGEN]) == tg, bar);
            __builtin_amdgcn_fence(__ATOMIC_ACQUIRE, "agent");
            xb_add(&bar[XB_XGEN(b.x)], 1u);
            asm volatile("s_waitcnt vmcnt(0)" ::: "memory");
        } else {
            XB_SPIN(xb_ld(&bar[XB_XGEN(b.x)]) == gen, bar);
            __builtin_amdgcn_fence(__ATOMIC_ACQUIRE, "agent");
            asm volatile("s_waitcnt vmcnt(0)" ::: "memory");
        }
    }
    __syncthreads();
}

struct Args { const float* in[20]; float* out; unsigned char* ws; };

struct Frame {
    LAS unsigned char* lds;
    int tid, lane, wave, G, gw, NGW;
};

__device__ __forceinline__ void transpose_item(const float* W, int ldw, int ldt, bf16_t* WT, int src_col0, int dst_row0, int k0, LAS float* scr, int lane) {
    float v[32];
    const float* wp = W + (size_t)(k0 + (lane >> 5)) * ldw + src_col0 + (lane & 31);
#pragma unroll
    for (int i = 0; i < 32; ++i) v[i] = wp[(size_t)(2 * i) * ldw];
#pragma unroll
    for (int i = 0; i < 32; ++i) { const int kk = 2 * i + (lane >> 5); scr[kk * 33 + (lane & 31)] = v[i]; }
    asm volatile("s_waitcnt lgkmcnt(0)" ::: "memory");
    const int c = lane & 7;
#pragma unroll
    for (int j = 0; j < 4; ++j) { const int n = (lane >> 3) + 8 * j; const LAS float* s = scr + (8 * c) * 33 + n;
        u32x4 o; o.x = pk2(s[0 * 33], s[1 * 33]); o.y = pk2(s[2 * 33], s[3 * 33]); o.z = pk2(s[4 * 33], s[5 * 33]); o.w = pk2(s[6 * 33], s[7 * 33]);
        *(u32x4*)(WT + (size_t)(dst_row0 + n) * ldt + k0 + 8 * c) = o; }
    asm volatile("s_waitcnt lgkmcnt(0)" ::: "memory");
}
__device__ __forceinline__ void conv_matrix(const Frame& F, const float* W, int ldw, int K, int ncols_dst, int mode, bf16_t* WT, int rot, int ldt = 0) {
    if (ldt == 0) ldt = K;
    LAS float* scr = (LAS float*)(F.lds + F.wave * 16384);
    const int nblk = ncols_dst / 32, nitems = (K / 64) * nblk;
    int start = F.gw - rot; if (start < 0) start += F.NGW;
    for (int it = start; it < nitems; it += F.NGW) {
        const int kb = it / nblk, nb = it % nblk;
        int src = 32 * nb, dst = 32 * nb;
        if (mode == 1) dst = 256 * (nb >> 2) + 32 * (nb & 3);
        else if (mode == 2) dst = 256 * (nb >> 2) + 128 + 32 * (nb & 3);
        else if (mode == 3) src = 32 * nb + (32 * nb >= 6144 ? 16 : 0);
        transpose_item(W, ldw, ldt, WT, src, dst, 64 * kb, scr, F.lane);
    }
}

__device__ __forceinline__ void load_gain(const float* gain, int lane, f32x4 (&gv)[8]) {
#pragma unroll
    for (int j = 0; j < 8; ++j) gv[j] = ((const f32x4*)gain + lane)[64 * j];
}
__device__ __forceinline__ void rms_row(const float* xrow, const f32x4 (&gv)[8], bf16_t* orow, int lane, f32x4 (&hv)[8]) {
    const f32x4* xr = (const f32x4*)xrow + lane;
    float s = 0.f;
#pragma unroll
    for (int j = 0; j < 8; ++j) { hv[j] = xr[64 * j]; s += (hv[j].x * hv[j].x + hv[j].y * hv[j].y) + (hv[j].z * hv[j].z + hv[j].w * hv[j].w); }
    const float r = 1.0f / sqrtf(wave_sum(s) * (1.0f / D) + RMS_EPS);
    u32x2* o8 = (u32x2*)orow + lane;
#pragma unroll
    for (int j = 0; j < 8; ++j) { hv[j] = hv[j] * r * gv[j]; u32x2 w; w.x = pk2(hv[j].x, hv[j].y); w.y = pk2(hv[j].z, hv[j].w); o8[64 * j] = w; }
}

__device__ __forceinline__ void row_load(const bf16_t* xrow, int lane, f32x4 (&xv)[8]) {
    const u32x2* xr = (const u32x2*)xrow + lane;
#pragma unroll
    for (int j = 0; j < 8; ++j) { const u32x2 w = xr[64 * j]; xv[j] = (f32x4){bflo(w.x), bfhi(w.x), bflo(w.y), bfhi(w.y)}; }
}
__device__ __forceinline__ void row_load(const float* xrow, int lane, f32x4 (&xv)[8]) {
    const f32x4* xr = (const f32x4*)xrow + lane;
#pragma unroll
    for (int j = 0; j < 8; ++j) xv[j] = xr[64 * j];
}
__device__ __forceinline__ void row_finish(f32x4 (&xv)[8], const f32x4 (&gv)[8], bf16_t* orow, int lane) {
    float s = 0.f;
#pragma unroll
    for (int j = 0; j < 8; ++j) s += (xv[j].x * xv[j].x + xv[j].y * xv[j].y) + (xv[j].z * xv[j].z + xv[j].w * xv[j].w);
    const float r = 1.0f / sqrtf(wave_sum(s) * (1.0f / D) + RMS_EPS);
    u32x2* o8 = (u32x2*)orow + lane;
#pragma unroll
    for (int j = 0; j < 8; ++j) { xv[j] = xv[j] * r * gv[j]; u32x2 w; w.x = pk2(xv[j].x, xv[j].y); w.y = pk2(xv[j].z, xv[j].w); o8[64 * j] = w; }
}
template <class XT>
__device__ __forceinline__ void rms_rows_pipelined(const Frame& F, const XT* X, const float* gain, bf16_t* Hout) {
    f32x4 gv[8], xa[8], xb[8]; load_gain(gain, F.lane, gv);
    int m = F.gw;
    if (m < M) row_load(X + (size_t)m * D, F.lane, xa);
    for (; m < M; m += F.NGW) {
        const int mn = m + F.NGW;
        if (mn < M) row_load(X + (size_t)mn * D, F.lane, xb);
        row_finish(xa, gv, Hout + (size_t)m * D, F.lane);
#pragma unroll
        for (int j = 0; j < 8; ++j) xa[j] = xb[j];
    }
}

typedef short v4i16_t __attribute__((ext_vector_type(4)));
typedef float f32x2_t __attribute__((ext_vector_type(2))); typedef __bf16 bf16x2_t __attribute__((ext_vector_type(2)));
__device__ __forceinline__ unsigned cvtpk_s(float lo, float hi) { f32x2_t v = {lo, hi}; bf16x2_t b = __builtin_convertvector(v, bf16x2_t); return __builtin_bit_cast(unsigned, b); }
__device__ __forceinline__ v4i16_t vtr(const LAS unsigned char* p) { return __builtin_amdgcn_ds_read_tr16_b64_v4i16((LAS v4i16_t*)p); }
#define MFMA16(a, b, c) __builtin_amdgcn_mfma_f32_16x16x32_bf16((a), (b), (c), 0, 0, 0)

template <int PASS>
__device__ __forceinline__ void attn_pass(const Frame& F, const bf16_t* QKVA, bf16_t* OACC, float* LACC, bf16_t* Hout, float nb2) {
    constexpr int d = 1 << (2 * PASS);
    constexpr int KST = 272, VST = 288;
    LAS unsigned char* Kl = F.lds; LAS unsigned char* Vl = F.lds + 256 * KST;
    int lane = F.lane; asm volatile("" : "+v"(lane));
    const int w = F.wave, g = lane >> 4, c = lane & 15, q4 = c >> 2, p4 = c & 3;
    constexpr float SCL = 0.08838834764831845f * 1.44269504089f;
    u32x4 kpre[8], vpre[8]; bf16x8 qpre[4];
    auto issue = [&](int idx) {
        const int h = idx & 7, blk = idx >> 3, r = blk % d, n = blk / d;
        { const size_t tqn = (size_t)(n * 128 + 16 * w + c) * d + r;
#pragma unroll
          for (int kk = 0; kk < 4; ++kk) qpre[kk] = *(const bf16x8*)(QKVA + tqn * 3072 + h * 128 + 8 * g + 32 * kk); }
#pragma unroll
        for (int u = 0; u < 8; ++u) {
            const int e = F.tid + 512 * u, row = e >> 4, ch = e & 15;
            int mrow = (n - 1) * 128 + row; if (mrow < 0) mrow = 0;
            const size_t t = (size_t)mrow * d + r;
            kpre[u] = *(const u32x4*)(QKVA + t * 3072 + 1024 + h * 128 + ch * 8);
            vpre[u] = *(const u32x4*)(QKVA + t * 3072 + 2048 + h * 128 + ch * 8);
        }
    };
    if ((int)blockIdx.x < 1024) issue(blockIdx.x);
    for (int idx = blockIdx.x; idx < 1024; idx += F.G) {
        const int h = idx & 7, blk = idx >> 3, r = blk % d, n = blk / d;
        __syncthreads();
#pragma unroll
        for (int u = 0; u < 8; ++u) {
            const int e = F.tid + 512 * u, row = e >> 4, ch = e & 15;
            *(LAS u32x4*)(Kl + row * KST + ch * 16) = kpre[u];
            *(LAS u32x4*)(Vl + row * VST + ch * 16) = vpre[u];
        }
        __syncthreads();
        bf16x8 qf[4];
#pragma unroll
        for (int kk = 0; kk < 4; ++kk) qf[kk] = qpre[kk];
        if (idx + F.G < 1024) issue(idx + F.G);
        const int qi = 16 * w + c;
        const size_t tq = (size_t)(n * 128 + qi) * d + r;
        f32x4 accO[8];
        bf16_t* op = OACC + tq * 1024 + h * 128 + 4 * g;
        float lsum = 0.f;
        if (PASS > 0) {
#pragma unroll
            for (int nt = 0; nt < 8; ++nt) { const u32x2 pv = *(const u32x2*)(op + 16 * nt); accO[nt] = (f32x4){bflo(pv.x), bfhi(pv.x), bflo(pv.y), bfhi(pv.y)}; }
            lsum = (g == 0) ? LACC[tq * 8 + h] : 0.f;
        } else {
#pragma unroll
            for (int nt = 0; nt < 8; ++nt) accO[nt] = (f32x4){0.f, 0.f, 0.f, 0.f};
        }
#pragma unroll 1
        for (int ks = 0; ks < 5; ++ks) {
            u32x4 pw;
#pragma unroll
            for (int half = 0; half < 2; ++half) {
                const int kt = w + 2 * ks + half; const int ktc = kt < 16 ? kt : 15;
                f32x4 sv = (f32x4){0.f, 0.f, 0.f, 0.f};
#pragma unroll
                for (int kk = 0; kk < 4; ++kk) { const bf16x8 a = *(const LAS bf16x8*)(Kl + (16 * ktc + c) * KST + (8 * g + 32 * kk) * 2); sv = MFMA16(a, qf[kk], sv); }
                float pj[4];
#pragma unroll
                for (int j = 0; j < 4; ++j) { const int kj = 16 * kt + 4 * g + j; const bool valid = (kj >= qi) && (kj <= qi + 128) && (n > 0 || kj >= 128);
                    pj[j] = valid ? __builtin_amdgcn_exp2f(sv[j] * SCL + nb2) : 0.f; lsum += pj[j]; }
                if (half == 0) { pw.x = cvtpk_s(pj[0], pj[1]); pw.y = cvtpk_s(pj[2], pj[3]); } else { pw.z = cvtpk_s(pj[0], pj[1]); pw.w = cvtpk_s(pj[2], pj[3]); }
            }
            const bf16x8 pa = __builtin_bit_cast(bf16x8, pw);
            const int kt0 = w + 2 * ks, kt1 = (kt0 + 1 < 16) ? kt0 + 1 : 15;
            const LAS unsigned char* v0 = Vl + (16 * kt0 + 4 * g + q4) * VST + 8 * p4;
            const LAS unsigned char* v1 = Vl + (16 * kt1 + 4 * g + q4) * VST + 8 * p4;
#pragma unroll
            for (int nt = 0; nt < 8; ++nt) {
                const v4i16_t lo = vtr(v0 + 32 * nt), hi = vtr(v1 + 32 * nt);
                const bf16x8 vf = __builtin_shufflevector(lo, hi, 0, 1, 2, 3, 4, 5, 6, 7);
                accO[nt] = MFMA16(vf, pa, accO[nt]);
            }
        }
        lsum += __shfl_xor(lsum, 16); lsum += __shfl_xor(lsum, 32);
        if (PASS < 2) {
#pragma unroll
            for (int nt = 0; nt < 8; ++nt) { u32x2 o; o.x = cvtpk_s(accO[nt][0], accO[nt][1]); o.y = cvtpk_s(accO[nt][2], accO[nt][3]); *(u32x2*)(op + 16 * nt) = o; }
            if (g == 0) LACC[tq * 8 + h] = lsum;
        } else {
            const float il = 1.0f / lsum;
            bf16_t* hp = Hout + tq * 2048 + h * 128 + 4 * g;
#pragma unroll
            for (int nt = 0; nt < 8; ++nt) { u32x2 o; o.x = cvtpk_s(accO[nt][0] * il, accO[nt][1] * il); o.y = cvtpk_s(accO[nt][2] * il, accO[nt][3] * il); *(u32x2*)(hp + 16 * nt) = o; }
        }
    }
    __syncthreads();
}

constexpr int GL_QT = 0, GL_KH = 17408, GL_KE = 34816, GL_V = 53248, GL_AM = 88064, GL_BZ = 97280, GL_TOT = 101376, GL_EBL = 103424, GL_RED = 103936, GL_CS = 105984;
constexpr int GL_ST = 272, GL_KST = 288, GL_VST = 544, GL_AST = 144;
template <int MODE>
__device__ __forceinline__ void gla_item(const Frame& F, int hh, int grp, const bf16_t* BB, const float* BZ, const float* w2g, const float* biasg, const float* gn, bf16_t* SLOC, float* DG, bf16_t* Hout) {
    LAS unsigned char* L = F.lds;
    const int tid = F.tid, lane = F.lane, w = F.wave; int g = lane >> 4, c = lane & 15; asm volatile("" : "+v"(g), "+v"(c));
    const int q4 = c >> 2, p4 = c & 3;
    const int dd = tid & 127, qr = tid >> 7;
    f32x4 S[8][2];
    bf16_t* sbase = SLOC + ((size_t)(hh * 64 + grp) * 128) * 256;
#pragma unroll
    for (int mt = 0; mt < 8; ++mt)
#pragma unroll
        for (int nt = 0; nt < 2; ++nt) {
            if (MODE == 0) S[mt][nt] = (f32x4){0.f, 0.f, 0.f, 0.f};
            else {
                { const u32x2 pw = *(const u32x2*)(sbase + (unsigned)((((mt * 2 + nt) * 8 + w) * 64 + (16 * g + c)) * 4)); S[mt][nt] = (f32x4){bflo(pw.x), bfhi(pw.x), bflo(pw.y), bfhi(pw.y)}; }
            }
        }
    float w2r[16];
#pragma unroll
    for (int r = 0; r < 16; ++r) w2r[r] = w2g[r * 512 + hh * 128 + dd];
    const float bias = biasg[hh * 128 + dd];
    float lsum_d = 0.f;
#pragma unroll 1
    for (int ch = 0; ch < 4; ++ch) {
        const int t0 = (grp * 4 + ch) * 64;
        __syncthreads();
        float* Bg = (float*)Hout + (size_t)t0 * 1024 + 512 + hh * 128 + dd;
        float bpre[16]; float total = 0.f;
        if (MODE == 0) { if (tid < 256) *(LAS f32x4*)(L + GL_BZ + tid * 16) = *(const f32x4*)(BZ + (size_t)t0 * 16 + tid * 4); }
        else {
#pragma unroll
            for (int ii = 0; ii < 16; ++ii) bpre[ii] = Bg[(size_t)(16 * qr + ii) * 1024];
            total = Bg[(size_t)63 * 1024];
        }
        {
            u32x4 vv[4], kv[2], qv[2];
#pragma unroll
            for (int u = 0; u < 4; ++u) { const int e = tid + 512 * u, row = e >> 5, cc = e & 31; vv[u] = *(const u32x4*)(BB + (size_t)(t0 + row) * 3072 + 1024 + hh * 256 + cc * 8); }
#pragma unroll
            for (int u = 0; u < 2; ++u) { const int e = tid + 512 * u, row = e >> 4, cc = e & 15; kv[u] = *(const u32x4*)(BB + (size_t)(t0 + row) * 3072 + 512 + hh * 128 + cc * 8);
                if (MODE == 1) qv[u] = *(const u32x4*)(BB + (size_t)(t0 + row) * 3072 + hh * 128 + cc * 8); }
#pragma unroll
            for (int u = 0; u < 4; ++u) { const int e = tid + 512 * u, row = e >> 5, cc = e & 31; *(LAS u32x4*)(L + GL_V + row * GL_VST + cc * 16) = vv[u]; }
#pragma unroll
            for (int u = 0; u < 2; ++u) { const int e = tid + 512 * u, row = e >> 4, cc = e & 15; *(LAS u32x4*)(L + GL_KE + row * GL_KST + cc * 16) = kv[u];
                if (MODE == 1) *(LAS u32x4*)(L + GL_QT + row * GL_ST + cc * 16) = qv[u]; }
        }
        __syncthreads();
        if (MODE == 0) {
            float run = 0.f;
            LAS float* csl = (LAS float*)(L + GL_CS);
#pragma unroll 2
            for (int ii = 0; ii < 16; ++ii) {
                const LAS float* bz = (const LAS float*)(L + GL_BZ) + (16 * qr + ii) * 16;
                float z = bias;
#pragma unroll
                for (int r = 0; r < 16; ++r) z += bz[r] * w2r[r];
                const float ls = -__logf(1.0f + __expf(-fmaxf(z, -80.f)));
                run += ls * (1.0f / 16.0f); csl[(16 * qr + ii) * 128 + dd] = run;
            }
            ((LAS float*)(L + GL_TOT))[qr * 128 + dd] = run;
            __syncthreads();
            float pre = 0.f;
#pragma unroll
            for (int qq = 0; qq < 4; ++qq) { const float tv = ((const LAS float*)(L + GL_TOT))[qq * 128 + dd]; total += tv; if (qq < qr) pre += tv; }
#pragma unroll 2
            for (int ii = 0; ii < 16; ++ii) {
                const int i = 16 * qr + ii; const float Bv = pre + csl[i * 128 + dd];
                Bg[(size_t)i * 1024] = Bv;
                const float kf = bf2f(*(const LAS bf16_t*)(L + GL_KE + i * GL_KST + dd * 2));
                *(LAS bf16_t*)(L + GL_KE + i * GL_KST + dd * 2) = (bf16_t)cvtpk_s(kf * __expf(total - Bv), 0.f);
            }
        } else {
#pragma unroll
            for (int ii = 0; ii < 16; ++ii) {
                const int i = 16 * qr + ii; const float Bv = bpre[ii];
                const float kf = bf2f(*(const LAS bf16_t*)(L + GL_KE + i * GL_KST + dd * 2));
                const float qf = bf2f(*(const LAS bf16_t*)(L + GL_QT + i * GL_ST + dd * 2));
                *(LAS bf16_t*)(L + GL_KE + i * GL_KST + dd * 2) = (bf16_t)cvtpk_s(kf * __expf(total - Bv), 0.f);
                *(LAS bf16_t*)(L + GL_QT + i * GL_ST + dd * 2) = (bf16_t)cvtpk_s(qf * 0.08838834764831845f * __expf(Bv), 0.f);
                *(LAS bf16_t*)(L + GL_KH + i * GL_ST + dd * 2) = (bf16_t)cvtpk_s(kf * __expf(fminf(-Bv, 60.f)), 0.f);
            }
        }
        if (qr == 0) { ((LAS float*)(L + GL_EBL))[dd] = __expf(total); lsum_d += total; }
        __syncthreads();
        bf16x8 vfr[2][2];
#pragma unroll
        for (int kk = 0; kk < 2; ++kk)
#pragma unroll
            for (int nt = 0; nt < 2; ++nt) {
                const LAS unsigned char* vp = L + GL_V + (32 * kk + 8 * g + q4) * GL_VST + (32 * w + 16 * nt + 4 * p4) * 2;
                const v4i16_t lo = vtr(vp), hi = vtr(vp + 4 * GL_VST);
                vfr[kk][nt] = __builtin_shufflevector(lo, hi, 0, 1, 2, 3, 4, 5, 6, 7);
            }
        if (MODE == 1) {
            {
                const int it = w >> 1;
#pragma unroll
                for (int jj = 0; jj < 2; ++jj) {
                    const int jt = 2 * (w & 1) + jj;
                    f32x4 a4 = (f32x4){0.f, 0.f, 0.f, 0.f};
#pragma unroll
                    for (int kk = 0; kk < 4; ++kk) {
                        const bf16x8 a = *(const LAS bf16x8*)(L + GL_QT + (16 * it + c) * GL_ST + (8 * g + 32 * kk) * 2);
                        const bf16x8 b = *(const LAS bf16x8*)(L + GL_KH + (16 * jt + c) * GL_ST + (8 * g + 32 * kk) * 2);
                        a4 = MFMA16(a, b, a4);
                    }
#pragma unroll
                    for (int j = 0; j < 4; ++j) { const int i = 16 * it + 4 * g + j, jc = 16 * jt + c;
                        *(LAS bf16_t*)(L + GL_AM + i * GL_AST + jc * 2) = (bf16_t)f2bf(jc <= i ? a4[j] : 0.f); }
                }
            }
            __syncthreads();
            f32x4 o[2][4];
#pragma unroll
            for (int mt = 0; mt < 2; ++mt)
#pragma unroll
                for (int it = 0; it < 4; ++it) o[mt][it] = (f32x4){0.f, 0.f, 0.f, 0.f};
#pragma unroll
            for (int kq = 0; kq < 4; ++kq) {
                bf16x8 qb[4];
#pragma unroll
                for (int it = 0; it < 4; ++it) {
                    const LAS unsigned char* qp = L + GL_QT + (16 * it + c) * GL_ST + (32 * kq + 4 * g) * 2;
                    const u32x2 lo = *(const LAS u32x2*)qp, hi = *(const LAS u32x2*)(qp + 32);
                    u32x4 t4; t4.x = lo.x; t4.y = lo.y; t4.z = hi.x; t4.w = hi.y; qb[it] = __builtin_bit_cast(bf16x8, t4);
                }
#pragma unroll
                for (int mt = 0; mt < 2; ++mt) {
                    u32x4 sp; const f32x4 s0 = S[2 * kq][mt], s1 = S[2 * kq + 1][mt];
                    sp.x = cvtpk_s(s0[0], s0[1]); sp.y = cvtpk_s(s0[2], s0[3]); sp.z = cvtpk_s(s1[0], s1[1]); sp.w = cvtpk_s(s1[2], s1[3]);
                    const bf16x8 sa = __builtin_bit_cast(bf16x8, sp);
#pragma unroll
                    for (int it = 0; it < 4; ++it) o[mt][it] = MFMA16(sa, qb[it], o[mt][it]);
                }
                __builtin_amdgcn_sched_barrier(0);
            }
#pragma unroll
            for (int kk = 0; kk < 2; ++kk) {
#pragma unroll
                for (int it = 0; it < 4; ++it) {
                    const bf16x8 ab = *(const LAS bf16x8*)(L + GL_AM + (16 * it + c) * GL_AST + (32 * kk + 8 * g) * 2);
#pragma unroll
                    for (int mt = 0; mt < 2; ++mt) o[mt][it] = MFMA16(vfr[kk][mt], ab, o[mt][it]);
                }
                __builtin_amdgcn_sched_barrier(0);
            }
            {
                LAS float* red = (LAS float*)(L + GL_RED);
                u32x2 bwv[2][2];
#pragma unroll
                for (int it = 0; it < 2; ++it)
#pragma unroll
                    for (int mt = 0; mt < 2; ++mt) bwv[it][mt] = *(const u32x2*)(BB + (size_t)(t0 + 16 * it + c) * 3072 + 2048 + hh * 256 + 32 * w + 16 * mt + 4 * g);
                const f32x4 gv0 = *(const f32x4*)(gn + 32 * w + 4 * g), gv1 = *(const f32x4*)(gn + 32 * w + 16 + 4 * g);
#pragma unroll
                for (int it = 0; it < 4; ++it) {
                    float ss = 0.f;
#pragma unroll
                    for (int mt = 0; mt < 2; ++mt) ss += (o[mt][it][0] * o[mt][it][0] + o[mt][it][1] * o[mt][it][1]) + (o[mt][it][2] * o[mt][it][2] + o[mt][it][3] * o[mt][it][3]);
                    ss += __shfl_xor(ss, 16); ss += __shfl_xor(ss, 32);
                    if (g == 0) red[w * 64 + 16 * it + c] = ss;
                }
                __syncthreads();
#pragma unroll
                for (int ih = 0; ih < 2; ++ih) {
                    if (ih == 1) {
#pragma unroll
                        for (int it = 0; it < 2; ++it)
#pragma unroll
                            for (int mt = 0; mt < 2; ++mt) bwv[it][mt] = *(const u32x2*)(BB + (size_t)(t0 + 16 * (2 + it) + c) * 3072 + 2048 + hh * 256 + 32 * w + 16 * mt + 4 * g);
                    }
#pragma unroll
                    for (int i2 = 0; i2 < 2; ++i2) {
                        const int it = 2 * ih + i2;
                        float tot = 0.f;
#pragma unroll
                        for (int ww = 0; ww < 8; ++ww) tot += red[ww * 64 + 16 * it + c];
                        const float rstd = 1.0f / sqrtf(tot * (1.0f / 256.0f) + RMS_EPS);
                        const size_t t = (size_t)(t0 + 16 * it + c);
#pragma unroll
                        for (int mt = 0; mt < 2; ++mt) {
                            const int dv0 = 32 * w + 16 * mt + 4 * g;
                            const f32x4 gv = mt ? gv1 : gv0;
                            const u32x2 bw = bwv[i2][mt];
                            u32x2 ow;
                            ow.x = pk2(o[mt][it][0] * rstd * gv.x * pg8::silu_(bflo(bw.x)), o[mt][it][1] * rstd * gv.y * pg8::silu_(bfhi(bw.x)));
                            ow.y = pk2(o[mt][it][2] * rstd * gv.z * pg8::silu_(bflo(bw.y)), o[mt][it][3] * rstd * gv.w * pg8::silu_(bfhi(bw.y)));
                            *(u32x2*)(Hout + t * 2048 + 1024 + hh * 256 + dv0) = ow;
                        }
                    }
                }
            }
        }
#pragma unroll
        for (int mt = 0; mt < 8; ++mt) {
            const f32x4 sc = *(const LAS f32x4*)(L + GL_EBL + (16 * mt + 4 * g) * 4);
            bf16x8 ka[2];
#pragma unroll
            for (int kk = 0; kk < 2; ++kk) {
                const LAS unsigned char* kp = L + GL_KE + (32 * kk + 8 * g + q4) * GL_KST + (16 * mt + 4 * p4) * 2;
                const v4i16_t lo = vtr(kp), hi = vtr(kp + 4 * GL_KST);
                ka[kk] = __builtin_shufflevector(lo, hi, 0, 1, 2, 3, 4, 5, 6, 7);
            }
#pragma unroll
            for (int nt = 0; nt < 2; ++nt) {
                f32x4 sv = S[mt][nt] * sc;
#pragma unroll
                for (int kk = 0; kk < 2; ++kk) sv = MFMA16(ka[kk], vfr[kk][nt], sv);
                S[mt][nt] = sv;
            }
            __builtin_amdgcn_sched_barrier(0);
        }
    }
    if (MODE == 0) {
#pragma unroll
        for (int mt = 0; mt < 8; ++mt)
#pragma unroll
            for (int nt = 0; nt < 2; ++nt)
                { u32x2 pw; pw.x = cvtpk_s(S[mt][nt][0], S[mt][nt][1]); pw.y = cvtpk_s(S[mt][nt][2], S[mt][nt][3]); *(u32x2*)(sbase + (unsigned)((((mt * 2 + nt) * 8 + w) * 64 + (16 * g + c)) * 4)) = pw; }
        if (qr == 0) DG[(hh * 64 + grp) * 128 + dd] = __expf(lsum_d);
    }
    __syncthreads();
}

__constant__ float c_rope_inv[16] = {1.0f, 0.44036660267178046f, 0.19392274474868576f, 0.08539710028576561f, 0.03760603093086393f, 0.016560440080994446f, 0.007292664737217109f, 0.003211445994752591f,
                                     0.001414213562373095f, 0.000622772421914596f, 0.0002742481756762073f, 0.00012076973741146504f, 5.318295896944988e-05f, 2.341999896140934e-05f, 1.031338537721246e-05f, 4.5416704806078695e-06f};

__global__ void __launch_bounds__(NWAVES * 64, 2) fwd_megakernel(Args args) {
    extern __shared__ __attribute__((aligned(16))) unsigned char lds_raw[];
    cg::grid_group grid = cg::this_grid();
    Frame F;
    F.lds = (LAS unsigned char*)lds_raw;
    F.tid = threadIdx.x; F.lane = F.tid & 63; F.wave = __builtin_amdgcn_readfirstlane(F.tid >> 6);
    F.G = gridDim.x; F.gw = blockIdx.x * NWAVES + F.wave; F.NGW = F.G * NWAVES;
    unsigned char* ws = args.ws;
    volatile LAS unsigned* bar_st = (volatile LAS unsigned*)(F.lds + LDS_BYTES - 16);
    if (F.tid < 2) bar_st[F.tid] = 0u;
    __syncthreads();
    const XcdBarrier xbar = xcd_barrier_post((unsigned*)(ws + WS_BAR), bar_st);
    const float* x = args.in[0]; const int* positions = (const int*)args.in[1];
    float* out = args.out;
    bf16_t* Wgu = (bf16_t*)(ws + WS_WGU); bf16_t* Wd = (bf16_t*)(ws + WS_WD); bf16_t* Win = (bf16_t*)(ws + WS_WIN);
    bf16_t* WupA = (bf16_t*)(ws + WS_WUPA);
    bf16_t* Wout = (bf16_t*)(ws + WS_WOUT);
    bf16_t* H = (bf16_t*)(ws + WS_H); bf16_t* ACT = (bf16_t*)(ws + WS_ACT);
    bf16_t* QKVA = (bf16_t*)(ws + WS_QKVA); bf16_t* BB = (bf16_t*)(ws + WS_BB); unsigned char* GATES = (unsigned char*)(ws + WS_GATES);
    bf16_t* X1B = (bf16_t*)args.out;
    bf16_t* X2B = (bf16_t*)(ws + WS_X2B);
    float* BZ = (float*)(ws + WS_BZ);
    bf16_t* Y = (bf16_t*)(ws + WS_Y);

    {
        conv_matrix(F, args.in[3], FF, D, FF, 1, Wgu, 0);
        conv_matrix(F, args.in[4], FF, D, FF, 2, Wgu, 0);
        conv_matrix(F, args.in[5], D, FF, D, 0, Wd, 0);
        conv_matrix(F, args.in[7], 10256, D, NPROJ, 3, Win, 0);
        conv_matrix(F, args.in[13], D, AW, D, 0, WupA, 0, D);
        conv_matrix(F, args.in[14], D, AW, D, 0, WupA + 1024, 1024, D);
        conv_matrix(F, args.in[15], D, D, D, 0, Wout, 0);
        rms_rows_pipelined(F, x, args.in[2], H);
    }
    grid.sync();
    {
        pg8::Gemm g{H, Wgu, M, 2 * FF, D, D, D}; pg8::StaticOrder S; S.init(M, 2 * FF, F.G, (int)blockIdx.x);
        pg8::EpiSwiGLU E{ACT, FF};
        pg8::gemm_phase<pg8::EpiSwiGLU, true>(F.lds, g, S, E);
    }
    xcd_barrier(xbar);
    {
        pg8::Gemm g{ACT, Wd, M, D, FF, FF, FF}; pg8::StaticOrder S; S.init(M, D, F.G, (int)blockIdx.x, 4);
        pg8::EpiResidX<true, false> E{x, X1B, 0.5f};
        pg8::gemm_phase<pg8::EpiResidX<true, false>, true>(F.lds, g, S, E);
    }
    xcd_barrier(xbar);
    {
        LAS float* wz = (LAS float*)F.lds;
        const float* w_in = args.in[7];
        for (int e = F.tid; e < D * 16; e += NWAVES * 64) { const int k = e >> 4, j = e & 15; wz[j * D + k] = w_in[(size_t)k * 10256 + 6144 + j]; }
        __syncthreads();
        f32x4 gv[8], h0[8], h1[8]; load_gain(args.in[6], F.lane, gv);
        for (int m = F.gw; m < M; m += 2 * F.NGW) {
            const int m1 = m + F.NGW; const bool two = m1 < M;
            row_load(X1B + (size_t)m * D, F.lane, h0);
            if (two) row_load(X1B + (size_t)m1 * D, F.lane, h1);
            row_finish(h0, gv, H + (size_t)m * D, F.lane);
            if (two) row_finish(h1, gv, H + (size_t)m1 * D, F.lane);
            float mine0 = 0.f, mine1 = 0.f;
#pragma unroll 1
            for (int j = 0; j < 16; ++j) {
                float a0 = 0.f, a1 = 0.f;
#pragma unroll
                for (int i = 0; i < 8; ++i) { const f32x4 w = *(const LAS f32x4*)(wz + j * D + 256 * i + 4 * F.lane);
                    a0 += (h0[i].x * w.x + h0[i].y * w.y) + (h0[i].z * w.z + h0[i].w * w.w);
                    a1 += (h1[i].x * w.x + h1[i].y * w.y) + (h1[i].z * w.z + h1[i].w * w.w); }
                a0 = wave_sum(a0); a1 = wave_sum(a1);
                if (F.lane == j) { mine0 = a0; mine1 = a1; }
            }
            if (F.lane < 16) { BZ[(size_t)m * 16 + F.lane] = mine0; if (two) BZ[(size_t)m1 * 16 + F.lane] = mine1; }
        }
        __syncthreads();
    }
    xcd_barrier(xbar);
    {
        pg8::Gemm g{H, Win, M, NPROJ, D, D, D}; pg8::StaticOrder S; S.init(M, NPROJ, F.G, (int)blockIdx.x); S.cperm = 1;
        pg8::EpiProj E{QKVA, BB, GATES};
        pg8::gemm_phase<pg8::EpiProj, true>(F.lds, g, S, E);
    }
    xcd_barrier(xbar);
    {
        const float* gq = args.in[8]; const float* gk = args.in[9]; const float* w2 = args.in[10]; const float* gb = args.in[11];
        const int lane = F.lane;
        for (int t = F.gw; t < M; t += F.NGW) {
            const float pos = (float)positions[t];
            unsigned* prow = (unsigned*)(QKVA + (size_t)t * 3072) + lane;
            unsigned wv[16];
#pragma unroll
            for (int v = 0; v < 16; ++v) wv[v] = prow[v * 64];
            float s0 = 0.f, c0 = 1.f, s1 = 0.f, c1 = 1.f;
            if (lane < 16) {
                const int i0 = (2 * lane) & 15;
                const float a0 = pos * c_rope_inv[i0], a1 = pos * c_rope_inv[i0 + 1];
                const double rv0 = (double)a0 * 0.15915494309189535, rv1 = (double)a1 * 0.15915494309189535;
                const float f0 = (float)(rv0 - rint(rv0)), f1 = (float)(rv1 - rint(rv1));
                s0 = __builtin_amdgcn_sinf(f0); c0 = __builtin_amdgcn_cosf(f0); s1 = __builtin_amdgcn_sinf(f1); c1 = __builtin_amdgcn_cosf(f1);
                if (lane < 8) { s0 = -s0; s1 = -s1; }
            }
            const float gq0 = gq[2 * lane], gq1 = gq[2 * lane + 1], gk0 = gk[2 * lane], gk1 = gk[2 * lane + 1];
#pragma unroll
            for (int v = 0; v < 16; ++v) {
                const float x0 = bflo(wv[v]), x1 = bfhi(wv[v]);
                const float ss = wave_sum(x0 * x0 + x1 * x1);
                const float r = 1.0f / sqrtf(ss * (1.0f / 128.0f) + RMS_EPS);
                float y0 = x0 * r * (v < 8 ? gq0 : gk0), y1 = x1 * r * (v < 8 ? gq1 : gk1);
                const float p0 = __shfl_xor(y0, 8), p1 = __shfl_xor(y1, 8);
                if (lane < 16) { y0 = y0 * c0 + p0 * s0; y1 = y1 * c1 + p1 * s1; }
                prow[v * 64] = pk2(y0, y1);
            }
        }
    }
    xcd_barrier(xbar);
    {
        bf16_t* OACC = (bf16_t*)(ws + WS_ORAW); float* LACC = (float*)ws;
        bf16_t* SLOC = (bf16_t*)(ws + WS_SLOC); float* DG = (float*)(ws + WS_DG);
        const float* gq = args.in[8]; const float* gk = args.in[9];
        const float mq = wave_max(fmaxf(fabsf(gq[2 * F.lane]), fabsf(gq[2 * F.lane + 1]))), mk = wave_max(fmaxf(fabsf(gk[2 * F.lane]), fabsf(gk[2 * F.lane + 1])));
        const float nb2 = -11.313708499f * mq * mk * 1.44269504089f;
        for (int it = blockIdx.x; it < 256; it += F.G) gla_item<0>(F, it >> 6, it & 63, BB, BZ, args.in[10], args.in[11], args.in[12], SLOC, DG, H);
        attn_pass<0>(F, QKVA, OACC, LACC, H, nb2);
        xcd_barrier(xbar);
        for (int e = blockIdx.x * 512 + F.tid; e < 4 * 128 * 256 / 2; e += F.G * 512) {
            const int hh = e >> 14, rem = (e & 16383) * 2, dk = 16 * (rem >> 12) + 4 * ((rem >> 6) & 3) + (rem & 3);
            float run0 = 0.f, run1 = 0.f;
#pragma unroll 1
            for (int g0 = 0; g0 < 64; g0 += 16) {
                unsigned tv[16]; f32x2 dv_[16];
#pragma unroll
                for (int u = 0; u < 16; ++u) { tv[u] = *(const unsigned*)(SLOC + (size_t)(hh * 64 + g0 + u) * 32768 + rem); dv_[u] = *(const f32x2*)(DG + (hh * 64 + g0 + u) * 128 + dk); }
#pragma unroll
                for (int u = 0; u < 16; ++u) { *(unsigned*)(SLOC + (size_t)(hh * 64 + g0 + u) * 32768 + rem) = cvtpk_s(run0, run1); run0 = dv_[u].x * run0 + bflo(tv[u]); run1 = dv_[u].y * run1 + bfhi(tv[u]); }
            }
        }
        attn_pass<1>(F, QKVA, OACC, LACC, H, nb2);
        xcd_barrier(xbar);
        for (int it = blockIdx.x; it < 256; it += F.G) gla_item<1>(F, it >> 6, it & 63, BB, BZ, args.in[10], args.in[11], args.in[12], SLOC, DG, H);
        attn_pass<2>(F, QKVA, OACC, LACC, H, nb2);
    }
    xcd_barrier(xbar);
    {
        pg8::StaticOrder S; S.init(M, D, F.G, (int)blockIdx.x, 4);
        pg8::Gemm g{H, WupA, M, D, D, D, D}; pg8::EpiGateY E{GATES, Y}; pg8::GateMid HK{GATES};
        pg8::gemm_phase<pg8::EpiGateY, true, pg8::GateMid>(F.lds, g, S, E, HK);
    }
    xcd_barrier(xbar);
    {
        pg8::Gemm g{Y, Wout, M, D, D, D, D}; pg8::StaticOrder S; S.init(M, D, F.G, (int)blockIdx.x, 4);
        pg8::EpiResidX<false, false> E{X1B, X2B, 1.0f};
        pg8::gemm_phase<pg8::EpiResidX<false, false>, true>(F.lds, g, S, E);
    }
    xcd_barrier(xbar);
    {
        conv_matrix(F, args.in[17], FF, D, FF, 1, Wgu, 0);
        conv_matrix(F, args.in[18], FF, D, FF, 2, Wgu, 0);
        conv_matrix(F, args.in[19], D, FF, D, 0, Wd, 0);
        rms_rows_pipelined(F, X2B, args.in[16], H);
    }
    xcd_barrier(xbar);
    {
        pg8::Gemm g{H, Wgu, M, 2 * FF, D, D, D}; pg8::StaticOrder S; S.init(M, 2 * FF, F.G, (int)blockIdx.x);
        pg8::EpiSwiGLU E{ACT, FF};
        pg8::gemm_phase<pg8::EpiSwiGLU, true>(F.lds, g, S, E);
    }
    xcd_barrier(xbar);
    {
        pg8::Gemm g{ACT, Wd, M, D, FF, FF, FF}; pg8::StaticOrder S; S.init(M, D, F.G, (int)blockIdx.x, 4);
        pg8::EpiResidX<false, true> E{X2B, out, 0.5f};
        pg8::gemm_phase<pg8::EpiResidX<false, true>, true>(F.lds, g, S, E);
    }
}

extern "C" void kernel_launch(void* const* d_in, const int* in_sizes, int n_in, void* d_out, int out_size, void* d_ws, size_t ws_size, hipStream_t stream) {
    static int grid = 0;
    if (grid == 0) {
        if (n_in != 20 || in_sizes[0] != M * D || out_size != M * D || ws_size < WS_END) { fprintf(stderr, "kernel_launch: unexpected shapes / workspace (n_in %d, ws %zu)\n", n_in, ws_size); grid = -1; return; }
        int dev = 0, cus = 0, per_cu = 0;
        (void)hipGetDevice(&dev); (void)hipDeviceGetAttribute(&cus, hipDeviceAttributeMultiprocessorCount, dev);
        if (hipFuncSetAttribute((const void*)fwd_megakernel, hipFuncAttributeMaxDynamicSharedMemorySize, LDS_BYTES) != hipSuccess) { fprintf(stderr, "kernel_launch: hipFuncSetAttribute failed\n"); grid = -1; return; }
        if (hipOccupancyMaxActiveBlocksPerMultiprocessor(&per_cu, (const void*)fwd_megakernel, NWAVES * 64, LDS_BYTES) != hipSuccess || per_cu < 1) { fprintf(stderr, "kernel_launch: occupancy query says %d\n", per_cu); (void)hipGetLastError(); }
        grid = cus;
    }
    if (grid < 0) return;
    if (hipMemsetAsync((char*)d_ws + WS_BAR, 0, 16384, stream) != hipSuccess) { fprintf(stderr, "kernel_launch: memset failed\n"); return; }
    Args a{};
    for (int i = 0; i < 20; ++i) a.in[i] = (const float*)d_in[i];
    a.out = (float*)d_out; a.ws = (unsigned char*)d_ws;
    void* kargs[] = {&a};
    hipError_t e = hipLaunchCooperativeKernel((const void*)fwd_megakernel, dim3(grid), dim3(NWAVES * 64), kargs, LDS_BYTES, stream);
    if (e != hipSuccess) fprintf(stderr, "cooperative launch failed: %s (grid %d)\n", hipGetErrorString(e), grid);
}
```
